# Optimizing an MI355X kernel written in HIP

```python
import jax, jax.numpy as jnp
from jax import lax
import numpy as np

D_MODEL = 2048
BATCH = 2
SEQ = 16384
DEPTH = 1

CHUNK = 64

D_MIX = D_MODEL
D_LRU = D_MIX // 2
D_POOL = D_MIX - D_LRU
LRU_HEADS = 16
LRU_HEAD_DIM = D_LRU // LRU_HEADS
CONV_WIDTH = 4
LRU_C = 8.0
POOL_WINDOWS = (2, 4, 8, 16)
POOL_GROUPS = len(POOL_WINDOWS)
POOL_GROUP_DIM = D_POOL // POOL_GROUPS
D_FF = ((8 * D_MODEL + 3 * 256 - 1) // (3 * 256)) * 256
N_MOD = 6
EPS = 1e-6

kernel_name = "hybrid_rglru_pool_swiglu_adaln"


def rmsnorm(x, g):
    xf = x.astype(jnp.float32)
    y = xf * lax.rsqrt(jnp.mean(xf * xf, axis=-1, keepdims=True) + EPS)
    return (y * g.astype(jnp.float32)).astype(x.dtype)


def modulate(h, shift, scale):
    return h * (1 + scale[:, None, :]) + shift[:, None, :]


def causal_dwconv(x, w, b):
    y = lax.conv_general_dilated(
        x, w[:, None, :].astype(x.dtype), window_strides=(1,),
        padding=[(CONV_WIDTH - 1, 0)],
        dimension_numbers=("NWC", "WIO", "NWC"),
        feature_group_count=x.shape[-1])
    return y + b.astype(x.dtype)


def rg_lru(x, w_a, b_a, w_i, b_i, lam):
    bsz, seq, _ = x.shape
    xf = x.astype(jnp.float32)
    xh = xf.reshape(bsz, seq, LRU_HEADS, LRU_HEAD_DIM)
    r = jax.nn.sigmoid(jnp.einsum("bshi,hij->bshj", xh, w_a.astype(jnp.float32)).reshape(bsz, seq, D_LRU)
                       + b_a.astype(jnp.float32))
    i = jax.nn.sigmoid(jnp.einsum("bshi,hij->bshj", xh, w_i.astype(jnp.float32)).reshape(bsz, seq, D_LRU)
                       + b_i.astype(jnp.float32))
    log_a = LRU_C * r * jax.nn.log_sigmoid(lam.astype(jnp.float32))
    a = jnp.exp(log_a)
    mult = jnp.sqrt(-jnp.expm1(2.0 * log_a))
    u = mult * (i * xf)

    def combine(left, right):
        a1, b1 = left
        a2, b2 = right
        return a1 * a2, a2 * b1 + b2

    _, h = lax.associative_scan(combine, (a, u), axis=1)
    return h


def pool_mixer(x, w_pool, ls_pool):
    bsz, seq, _ = x.shape
    xf = x.astype(jnp.float32)
    cs0 = jnp.concatenate([jnp.zeros((bsz, 1, D_POOL), jnp.float32), jnp.cumsum(xf, axis=1)], axis=1)
    pos1 = jnp.arange(1, seq + 1, dtype=jnp.float32)
    outs = []
    for g, w in enumerate(POOL_WINDOWS):
        sl = slice(g * POOL_GROUP_DIM, (g + 1) * POOL_GROUP_DIM)
        c0 = cs0[..., sl]
        upper = c0[:, 1:]
        lower = jnp.concatenate([jnp.zeros((bsz, w - 1, POOL_GROUP_DIM), jnp.float32),
                                 c0[:, :seq - w + 1]], axis=1)
        count = jnp.minimum(pos1, float(w))[None, :, None]
        outs.append((upper - lower) / count - xf[..., sl])
    pooled = jnp.stack(outs, axis=2)
    y = jnp.einsum("bsgc,gcd->bsgd", pooled, w_pool.astype(jnp.float32)) * ls_pool.astype(jnp.float32)
    return y.reshape(bsz, seq, D_POOL)


def setup_inputs(seed: int = 0) -> dict:
    key = jax.random.key(seed)
    ks = jax.random.split(key, 24)
    f32 = jnp.float32
    nrm = lambda k, shape, s: jax.random.normal(k, shape, f32) * s
    a0 = jax.random.uniform(ks[12], (DEPTH, D_LRU), f32, 0.9, 0.999)
    s0 = a0 ** (1.0 / LRU_C)
    lam = jnp.log(s0) - jnp.log1p(-s0)
    return {
        "x": nrm(ks[0], (BATCH, SEQ, D_MODEL), 1.0),
        "c": nrm(ks[1], (BATCH, D_MODEL), 1.0),
        "w_ada": nrm(ks[2], (DEPTH, D_MODEL, N_MOD * D_MODEL), 0.5 * D_MODEL ** -0.5),
        "b_ada": nrm(ks[3], (DEPTH, N_MOD * D_MODEL), 0.02),
        "g_norm_mix": 1.0 + nrm(ks[4], (DEPTH, D_MODEL), 0.05),
        "w_in": nrm(ks[5], (DEPTH, D_MODEL, 2 * D_LRU + D_POOL), D_MODEL ** -0.5),
        "w_conv": nrm(ks[6], (DEPTH, CONV_WIDTH, D_LRU), CONV_WIDTH ** -0.5),
        "b_conv": nrm(ks[7], (DEPTH, D_LRU), 0.02),
        "w_rg_a": nrm(ks[8], (DEPTH, LRU_HEADS, LRU_HEAD_DIM, LRU_HEAD_DIM), LRU_HEAD_DIM ** -0.5),
        "b_rg_a": nrm(ks[9], (DEPTH, D_LRU), 0.02),
        "w_rg_i": nrm(ks[10], (DEPTH, LRU_HEADS, LRU_HEAD_DIM, LRU_HEAD_DIM), LRU_HEAD_DIM ** -0.5),
        "b_rg_i": nrm(ks[11], (DEPTH, D_LRU), 0.02),
        "lru_lambda": lam,
        "w_pool": nrm(ks[13], (DEPTH, POOL_GROUPS, POOL_GROUP_DIM, POOL_GROUP_DIM), POOL_GROUP_DIM ** -0.5),
        "ls_pool": 1.0 + nrm(ks[14], (DEPTH, POOL_GROUPS, POOL_GROUP_DIM), 0.1),
        "w_out": nrm(ks[15], (DEPTH, D_MIX, D_MODEL), D_MIX ** -0.5),
        "g_norm_ffn": 1.0 + nrm(ks[16], (DEPTH, D_MODEL), 0.05),
        "w_ffn_gate": nrm(ks[17], (DEPTH, D_MODEL, D_FF), D_MODEL ** -0.5),
        "w_ffn_up": nrm(ks[18], (DEPTH, D_MODEL, D_FF), D_MODEL ** -0.5),
        "w_ffn_down": nrm(ks[19], (DEPTH, D_FF, D_MODEL), D_FF ** -0.5),
        "g_norm_final": 1.0 + nrm(ks[20], (D_MODEL,), 0.05),
    }


def reference(x, c, w_ada, b_ada, g_norm_mix, w_in, w_conv, b_conv, w_rg_a, b_rg_a,
              w_rg_i, b_rg_i, lru_lambda, w_pool, ls_pool, w_out, g_norm_ffn,
              w_ffn_gate, w_ffn_up, w_ffn_down, g_norm_final):
    dt = x.dtype
    c_act = jax.nn.silu(c)
    for l in range(DEPTH):
        mod = c_act @ w_ada[l] + b_ada[l]
        sh1, sc1, gt1, sh2, sc2, gt2 = jnp.split(mod, N_MOD, axis=-1)

        h = modulate(rmsnorm(x, g_norm_mix[l]), sh1, sc1)
        proj = h @ w_in[l]
        xr = proj[..., :D_LRU]
        gr = proj[..., D_LRU:2 * D_LRU]
        xp = proj[..., 2 * D_LRU:]
        xr = causal_dwconv(xr, w_conv[l], b_conv[l])
        hr = rg_lru(xr, w_rg_a[l], b_rg_a[l], w_rg_i[l], b_rg_i[l], lru_lambda[l])
        y_lru = (hr * jax.nn.gelu(gr.astype(jnp.float32))).astype(dt)
        y_pool = pool_mixer(xp, w_pool[l], ls_pool[l]).astype(dt)
        y = jnp.concatenate([y_lru, y_pool], axis=-1) @ w_out[l]
        x = x + gt1[:, None, :] * y

        h = modulate(rmsnorm(x, g_norm_ffn[l]), sh2, sc2)
        f = (jax.nn.silu(h @ w_ffn_gate[l]) * (h @ w_ffn_up[l])) @ w_ffn_down[l]
        x = x + gt2[:, None, :] * f
    return rmsnorm(x, g_norm_final)
```

```cpp
#include <hip/hip_runtime.h>
#include <hip/hip_cooperative_groups.h>
#include <cstdio>
#include <cstdint>
namespace cg = cooperative_groups;

#define LAS __attribute__((address_space(3)))
typedef unsigned short bf16_t;
typedef short bf16x8 __attribute__((ext_vector_type(8)));
typedef float f32x4 __attribute__((ext_vector_type(4)));
typedef unsigned u32x4 __attribute__((ext_vector_type(4)));
typedef unsigned u32x2 __attribute__((ext_vector_type(2)));

constexpr int Dm = 2048, NB = 2, SEQ = 16384, T = NB * SEQ, DLRU = 1024, NPROJ = 3072, DFF = 5632, NGU = 2 * DFF, NMOD = 6 * Dm;
constexpr int TC = 256, NCH = SEQ / TC;
constexpr int NTHREADS = 512, NWAVES = 8;
constexpr float EPS = 1e-6f;
constexpr float LOG2E = 1.4426950408889634f;

struct Params {
    const float *x, *c, *w_ada, *b_ada, *g_mix, *w_in, *w_conv, *b_conv, *w_rg_a, *b_rg_a, *w_rg_i, *b_rg_i, *lam, *w_pool, *ls_pool, *w_out, *g_ffn, *w_gate, *w_up, *w_down, *g_final;
    float* out;
    bf16_t *WinT, *WoutT, *WguT, *WdT, *WpT, *WAf;
    float *mod, *aggP, *aggE;
    bf16_t *HB, *proj, *pooled, *ycat, *act;
    float* x1;
};

__device__ __forceinline__ unsigned cvt_pk_bf16(float lo, float hi) { unsigned r; asm("v_cvt_pk_bf16_f32 %0, %1, %2" : "=v"(r) : "v"(lo), "v"(hi)); return r; }
__device__ __forceinline__ float bf_lo(unsigned w) { return __uint_as_float(w << 16); }
__device__ __forceinline__ float bf_hi(unsigned w) { return __uint_as_float(w & 0xffff0000u); }
__device__ __forceinline__ float fast_sigmoid(float v) { return __builtin_amdgcn_rcpf(1.0f + __builtin_amdgcn_exp2f(-LOG2E * v)); }
__device__ __forceinline__ float wave_sum(float v) {
#pragma unroll
    for (int o = 1; o < 64; o <<= 1) v += __shfl_xor(v, o);
    return v;
}

namespace pg8 {
constexpr int BM = 256, BK = 64, HALF = 128, HTB = HALF * BK * 2  , STAGE_BYTES = 8 * HTB, NXCD = 8, WGM = 8;

__host__ __device__ __forceinline__ int lds_byte(int r, int c) { const int st = (r >> 4) * 2 + (c >> 5), rr = r & 15, cc = c & 31, ob = rr * 64 + cc * 2; return st * 1024 + (ob ^ (((ob >> 9) & 1) << 5)); }
__host__ __device__ __forceinline__ void stage_rc(int b, int& R, int& C) { const int st = b / 1024, sb = b % 1024, swz = sb ^ (((sb >> 9) & 1) << 5); R = (st >> 1) * 16 + swz / 64; C = (st & 1) * 32 + (swz % 64) / 2; }
__host__ __device__ __forceinline__ int perm32(int rho) { const int n = rho >> 4, i = rho & 15; return 8 * (i >> 2) + 4 * n + (i & 3); }

struct Unit { int pm, pn; };
struct Gemm { const bf16_t* A; const bf16_t* Bt; int M, N, K, lda, ldb, a_pn_off; };

struct StaticOrder {
    int nM, nN, nwg, G, c;
    __host__ __device__ void init(int M, int N, int G_, int c_) { nM = M / BM; nN = N / BM; nwg = nM * nN; G = G_; c = c_; }
    __host__ __device__ bool next(int i, Unit& u) const {
        const long L = (long)i * G + c; if (L >= nwg) return false;
        int wgid = (int)L; { const int q = nwg / NXCD, r = nwg % NXCD, xcd = wgid % NXCD, off = wgid / NXCD; wgid = (xcd < r ? xcd * (q + 1) : r * (q + 1) + (xcd - r) * q) + off; }
        const int nig = WGM * nN, gid = wgid / nig, fm = gid * WGM, gsz = (nM - fm) < WGM ? (nM - fm) : WGM;
        u.pm = fm + ((wgid % nig) % gsz); u.pn = (wgid % nig) / gsz; return true;
    }
};

struct EpiBf16 {
    static constexpr bool PERM = true;
    bf16_t* O; int ldc;
    __device__ __forceinline__ void operator()(const f32x4 (&acc)[2][2][4][2], const Unit& u, int wr, int wc, int fr, int fq) const {
        const int row0 = u.pm * BM + wr * 64 + fr, col0 = u.pn * BM + wc * 32 + 8 * fq;
#pragma unroll
        for (int ai = 0; ai < 2; ++ai)
#pragma unroll
            for (int m = 0; m < 4; ++m) { bf16_t* rowp = O + (size_t)(row0 + ai * HALF + m * 16) * ldc + col0;
#pragma unroll
                for (int bj = 0; bj < 2; ++bj) { const f32x4 v0 = acc[ai][bj][m][0], v1 = acc[ai][bj][m][1];
                    u32x4 w; w.x = cvt_pk_bf16(v0[0], v0[1]); w.y = cvt_pk_bf16(v0[2], v0[3]); w.z = cvt_pk_bf16(v1[0], v1[1]); w.w = cvt_pk_bf16(v1[2], v1[3]);
                    *(u32x4*)(rowp + bj * HALF) = w; } }
    }
};
struct EpiResid {
    static constexpr bool PERM = false;
    float* out; const float* base; const float* gate;
    __device__ __forceinline__ void operator()(const f32x4 (&acc)[2][2][4][2], const Unit& u, int wr, int wc, int fr, int fq) const {
        const int row0 = u.pm * BM + wr * 64 + fr, col0 = u.pn * BM + wc * 32 + 4 * fq;
        const float* gp = gate + (size_t)(u.pm >> 6) * NMOD + col0;
        f32x4 gv[2][2];
#pragma unroll
        for (int bj = 0; bj < 2; ++bj)
#pragma unroll
            for (int n = 0; n < 2; ++n) gv[bj][n] = *(const f32x4*)(gp + bj * HALF + n * 16);
#pragma unroll
        for (int ai = 0; ai < 2; ++ai)
#pragma unroll
            for (int m = 0; m < 4; ++m) { const size_t ro = (size_t)(row0 + ai * HALF + m * 16) * Dm + col0;
#pragma unroll
                for (int bj = 0; bj < 2; ++bj)
#pragma unroll
                    for (int n = 0; n < 2; ++n) { const f32x4 bv = *(const f32x4*)(base + ro + bj * HALF + n * 16);
                        *(f32x4*)(out + ro + bj * HALF + n * 16) = bv + gv[bj][n] * acc[ai][bj][m][n]; } }
    }
};
struct EpiSwiglu {
    static constexpr bool PERM = true;
    bf16_t* O;
    __device__ __forceinline__ void operator()(const f32x4 (&acc)[2][2][4][2], const Unit& u, int wr, int wc, int fr, int fq) const {
        const int row0 = u.pm * BM + wr * 64 + fr, col0 = u.pn * HALF + wc * 32 + 8 * fq;
#pragma unroll
        for (int ai = 0; ai < 2; ++ai)
#pragma unroll
            for (int m = 0; m < 4; ++m) { bf16_t* rowp = O + (size_t)(row0 + ai * HALF + m * 16) * DFF + col0;
                f32x4 v0, v1;
#pragma unroll
                for (int j = 0; j < 4; ++j) { const float g0 = acc[ai][0][m][0][j], g1 = acc[ai][0][m][1][j];
                    v0[j] = g0 * fast_sigmoid(g0) * acc[ai][1][m][0][j]; v1[j] = g1 * fast_sigmoid(g1) * acc[ai][1][m][1][j]; }
                u32x4 w; w.x = cvt_pk_bf16(v0[0], v0[1]); w.y = cvt_pk_bf16(v0[2], v0[3]); w.z = cvt_pk_bf16(v1[0], v1[1]); w.w = cvt_pk_bf16(v1[2], v1[3]);
                *(u32x4*)rowp = w; }
    }
};

template <class Epi, class Sched, bool ALIGN_EPI = true>
__device__ __forceinline__ void gemm_phase(LAS unsigned char* lds, const Gemm g, const Sched& S, const Epi& E) {
    const int tid = threadIdx.x, wid = __builtin_amdgcn_readfirstlane(tid >> 6), lane = tid & 63, wr = wid >> 2, wc = wid & 3, fr = lane & 15, fq = lane >> 4;
    const int K = g.K, nt = K / BK;
    unsigned voffA[2], voffB[2];
#pragma unroll
    for (int i = 0; i < 2; ++i) { int R, C; stage_rc(tid * 16 + i * 8192, R, C); const int Rb = Epi::PERM ? ((R & ~31) + perm32(R & 31)) : R;
        voffA[i] = (unsigned)(R * g.lda + C) * 2u; voffB[i] = (unsigned)(Rb * g.ldb + C) * 2u; }
    const size_t kstep = (size_t)(BK * 2);
    const size_t hstepA = (size_t)HALF * g.lda * 2, hstepB = (size_t)HALF * g.ldb * 2;
    const size_t tstepA = 2 * hstepA, tstepB = 2 * hstepB;
    const unsigned ldsw = (unsigned)wid * 1024u;
    const int aoff = lds_byte(wr * 64 + fr, fq * 8), boff = lds_byte(wc * 32 + fr, fq * 8);
#define PG8_SA(b, h) (((b) * 2 + (h)) * HTB)
#define PG8_SB(b, h) ((4 + (b) * 2 + (h)) * HTB)
#define PG8_STAGE(bufoff, gbase, voff) do { _Pragma("unroll") for (int _i = 0; _i < 2; ++_i) \
        __builtin_amdgcn_global_load_lds((const unsigned*)((const char*)(gbase) + (voff)[_i]), (LAS unsigned*)(lds + (bufoff) + ldsw + _i * 8192), 16, 0, 0); } while (0)
#define PG8_LDA(dst, b, h) do { _Pragma("unroll") for (int m = 0; m < 4; ++m) _Pragma("unroll") for (int k = 0; k < 2; ++k) dst[m][k] = *(const LAS bf16x8*)(lds + PG8_SA(b, h) + aoff + m * 2048 + k * 1024); } while (0)
#define PG8_LDB(dst, b, h) do { _Pragma("unroll") for (int n = 0; n < 2; ++n) _Pragma("unroll") for (int k = 0; k < 2; ++k) dst[n][k] = *(const LAS bf16x8*)(lds + PG8_SB(b, h) + boff + n * 2048 + k * 1024); } while (0)
#define PG8_MMA(ai, bj, At, Bt) do { __builtin_amdgcn_s_setprio(1); _Pragma("unroll") for (int m = 0; m < 4; ++m) _Pragma("unroll") for (int n = 0; n < 2; ++n) _Pragma("unroll") for (int k = 0; k < 2; ++k) \
        acc[ai][bj][m][n] = __builtin_amdgcn_mfma_f32_16x16x32_bf16(Bt[n][k], At[m][k], acc[ai][bj][m][n], 0, 0, 0); __builtin_amdgcn_s_setprio(0); } while (0)
#define PG8_WAIT_V(n) asm volatile("s_waitcnt vmcnt(" #n ")" ::: "memory")
#define PG8_WAIT_L(n) asm volatile("s_waitcnt lgkmcnt(" #n ")" ::: "memory")
#define PG8_BAR __builtin_amdgcn_s_barrier()
#define PG8_SCHED __builtin_amdgcn_sched_barrier(0)
    Unit cur, nxt; int ui = 0;
    if (!S.next(0, cur)) return;
    f32x4 acc[2][2][4][2];
#pragma unroll
    for (int a = 0; a < 2; ++a)
#pragma unroll
        for (int b = 0; b < 2; ++b)
#pragma unroll
            for (int m = 0; m < 4; ++m)
#pragma unroll
                for (int n = 0; n < 2; ++n) acc[a][b][m][n] = (f32x4){0.f, 0.f, 0.f, 0.f};
    bf16x8 At[4][2], B0[2][2], B1[2][2];
    const char* cA = (const char*)g.A + (size_t)cur.pm * tstepA + (size_t)cur.pn * g.a_pn_off; const char* cB = (const char*)g.Bt + (size_t)cur.pn * tstepB;
    PG8_STAGE(PG8_SB(0, 0), cB, voffB); PG8_STAGE(PG8_SB(0, 1), cB + hstepB, voffB); PG8_STAGE(PG8_SA(0, 0), cA, voffA); PG8_STAGE(PG8_SA(0, 1), cA + hstepA, voffA);
    if (wr == 1) PG8_BAR;
    PG8_WAIT_V(2); PG8_BAR;
    PG8_STAGE(PG8_SB(1, 0), cB + kstep, voffB); PG8_STAGE(PG8_SA(1, 0), cA + kstep, voffA); PG8_STAGE(PG8_SB(1, 1), cB + hstepB + kstep, voffB);
    PG8_WAIT_V(6); PG8_BAR;
    for (;;) {
        const bool has_next = S.next(ui + 1, nxt);
        const char* nA = has_next ? (const char*)g.A + (size_t)nxt.pm * tstepA + (size_t)nxt.pn * g.a_pn_off : cA; const char* nB = has_next ? (const char*)g.Bt + (size_t)nxt.pn * tstepB : cB;
        for (int t = 0; t < nt; t += 2) {
            const bool last = (t == nt - 2);
            const char* a1 = cA + (size_t)(t + 1) * kstep;
            const char* a2 = last ? nA : cA + (size_t)(t + 2) * kstep; const char* b2 = last ? nB : cB + (size_t)(t + 2) * kstep;
            const char* a3 = a2 + kstep; const char* b3 = b2 + kstep;
            PG8_LDB(B0, 0, 0); PG8_LDB(B1, 0, 1); PG8_SCHED; PG8_LDA(At, 0, 0); PG8_STAGE(PG8_SA(1, 1), a1 + hstepA, voffA);
            PG8_WAIT_V(8); PG8_WAIT_L(0); PG8_BAR; PG8_MMA(0, 0, At, B0); PG8_MMA(0, 1, At, B1); PG8_BAR; PG8_SCHED;
            PG8_LDA(At, 0, 1); PG8_STAGE(PG8_SB(0, 0), b2, voffB); PG8_STAGE(PG8_SB(0, 1), b2 + hstepB, voffB); PG8_STAGE(PG8_SA(0, 0), a2, voffA);
            PG8_WAIT_V(8); PG8_WAIT_L(0); PG8_BAR; PG8_MMA(1, 0, At, B0); PG8_MMA(1, 1, At, B1); PG8_BAR; PG8_SCHED;
            PG8_LDB(B0, 1, 0); PG8_LDB(B1, 1, 1); PG8_SCHED; PG8_LDA(At, 1, 0); PG8_STAGE(PG8_SA(0, 1), a2 + hstepA, voffA);
            PG8_WAIT_V(8); PG8_WAIT_L(0); PG8_BAR; PG8_MMA(0, 0, At, B0); PG8_MMA(0, 1, At, B1); PG8_BAR; PG8_SCHED;
            PG8_LDA(At, 1, 1); PG8_STAGE(PG8_SB(1, 0), b3, voffB); PG8_STAGE(PG8_SB(1, 1), b3 + hstepB, voffB); PG8_STAGE(PG8_SA(1, 0), a3, voffA);
            PG8_WAIT_V(8); PG8_WAIT_L(0); PG8_BAR; PG8_MMA(1, 0, At, B0); PG8_MMA(1, 1, At, B1); PG8_BAR; PG8_SCHED;
        }
        if constexpr (ALIGN_EPI) { if (wr == 0) PG8_BAR; }
        E(acc, cur, wr, wc, fr, fq);
        if (!has_next) break;
#pragma unroll
        for (int a = 0; a < 2; ++a)
#pragma unroll
            for (int b = 0; b < 2; ++b)
#pragma unroll
                for (int m = 0; m < 4; ++m)
#pragma unroll
                    for (int n = 0; n < 2; ++n) acc[a][b][m][n] = (f32x4){0.f, 0.f, 0.f, 0.f};
        cur = nxt; cA = nA; cB = nB; ++ui;
        if constexpr (ALIGN_EPI) { if (wr == 1) PG8_BAR; }
    }
    PG8_WAIT_V(0);
    if constexpr (!ALIGN_EPI) { if (wr == 0) PG8_BAR; }
    PG8_BAR;
#undef PG8_SA
#undef PG8_SB
#undef PG8_STAGE
#undef PG8_LDA
#undef PG8_LDB
#undef PG8_MMA
#undef PG8_WAIT_V
#undef PG8_WAIT_L
#undef PG8_BAR
#undef PG8_SCHED
}
}

__device__ __forceinline__ void mod_task(const Params& p, LAS float* lds, int jg) {
    const int tid = threadIdx.x;
    LAS float* sc = lds;
    LAS float* red = lds + 4096;
    for (int i = tid; i < NB * Dm; i += NTHREADS) { const float v = p.c[i]; sc[i] = v * fast_sigmoid(v); }
    __syncthreads();
    const int c4 = tid & 31, ks = tid >> 5;
    const float* wp = p.w_ada + (size_t)(ks * 128) * NMOD + jg * 128 + c4 * 4;
    f32x4 a0 = (f32x4){0.f, 0.f, 0.f, 0.f}, a1 = a0;
#pragma unroll 8
    for (int kk = 0; kk < 128; ++kk) {
        const f32x4 w = *(const f32x4*)(wp + (size_t)kk * NMOD);
        const float s0 = sc[ks * 128 + kk], s1 = sc[Dm + ks * 128 + kk];
        a0 += s0 * w; a1 += s1 * w;
    }
    *(LAS f32x4*)(red + (ks * 2 + 0) * 128 + c4 * 4) = a0;
    *(LAS f32x4*)(red + (ks * 2 + 1) * 128 + c4 * 4) = a1;
    __syncthreads();
    if (tid < 256) { const int b = tid >> 7, j = tid & 127; float s = p.b_ada[jg * 128 + j];
#pragma unroll
        for (int k2 = 0; k2 < 16; ++k2) s += red[(k2 * 2 + b) * 128 + j];
        p.mod[(size_t)b * NMOD + jg * 128 + j] = s; }
    __syncthreads();
}
__device__ __forceinline__ void transpose_tile(const float* src, int N, bf16_t* dst, int ldd, int mode, const float* scale, int tile, LAS float* lds) {
    const int tid = threadIdx.x, ntn = N >> 6, kt = tile / ntn, ntile = tile - kt * ntn, k0 = kt * 64, n0 = ntile * 64;
    { const int kr = tid >> 4, n4 = (tid & 15) * 4;
#pragma unroll
      for (int i = 0; i < 2; ++i) { const f32x4 v = *(const f32x4*)(src + (size_t)(k0 + kr + 32 * i) * N + n0 + n4);
          LAS float* d = lds + (kr + 32 * i) * 65 + n4; d[0] = v[0]; d[1] = v[1]; d[2] = v[2]; d[3] = v[3]; } }
    __syncthreads();
    { const int n = tid >> 3, k8 = tid & 7; const LAS float* s = lds + (k8 * 8) * 65 + n; const int nn = n0 + n;
      const float sc = scale ? scale[nn] : 1.0f;
      u32x4 o; o.x = cvt_pk_bf16(s[0] * sc, s[65] * sc); o.y = cvt_pk_bf16(s[2 * 65] * sc, s[3 * 65] * sc); o.z = cvt_pk_bf16(s[4 * 65] * sc, s[5 * 65] * sc); o.w = cvt_pk_bf16(s[6 * 65] * sc, s[7 * 65] * sc);
      const int drow = mode == 0 ? nn : (256 * (nn >> 7) + (nn & 127) + (mode == 2 ? 128 : 0));
      *(u32x4*)(dst + (size_t)drow * ldd + k0 + k8 * 8) = o; }
    __syncthreads();
}
__device__ __forceinline__ void phase0(const Params& p, LAS float* lds) {
    const int G = gridDim.x;
    constexpr int T_MOD = NMOD / 128;
    constexpr int T_IN = (Dm / 64) * (NPROJ / 64), T_OUT = (Dm / 64) * (Dm / 64), T_G = (Dm / 64) * (DFF / 64), T_D = (DFF / 64) * (Dm / 64), T_P = 4 * 16;
    constexpr int NTASK = T_MOD + T_IN + T_OUT + 2 * T_G + T_D + T_P;
    for (int task = blockIdx.x; task < NTASK; task += G) {
        int r = task;
        if (r < T_MOD) { mod_task(p, lds, r); continue; } r -= T_MOD;
        if (r < T_IN) { transpose_tile(p.w_in, NPROJ, p.WinT, Dm, 0, nullptr, r, lds); continue; } r -= T_IN;
        if (r < T_OUT) { transpose_tile(p.w_out, Dm, p.WoutT, Dm, 0, nullptr, r, lds); continue; } r -= T_OUT;
        if (r < T_G) { transpose_tile(p.w_gate, DFF, p.WguT, Dm, 1, nullptr, r, lds); continue; } r -= T_G;
        if (r < T_G) { transpose_tile(p.w_up, DFF, p.WguT, Dm, 2, nullptr, r, lds); continue; } r -= T_G;
        if (r < T_D) { transpose_tile(p.w_down, Dm, p.WdT, DFF, 0, nullptr, r, lds); continue; } r -= T_D;
        { const int gidx = r >> 4; transpose_tile(p.w_pool + (size_t)gidx * 65536, 256, p.WpT + (size_t)gidx * 65536, 256, 0, p.ls_pool + gidx * 256, r & 15, lds); }
    }
    for (int e = blockIdx.x * NTHREADS + threadIdx.x; e < 2 * 16 * 4096; e += G * NTHREADS) {
        const int el = e & 7, ln = (e >> 3) & 63, ks = (e >> 9) & 1, mt = (e >> 10) & 3, h = (e >> 12) & 15, gate = e >> 16;
        const int in = ks * 32 + (ln >> 4) * 8 + el, out = mt * 16 + (ln & 15);
        const float* w = gate ? p.w_rg_i : p.w_rg_a;
        p.WAf[e] = (bf16_t)(cvt_pk_bf16(w[(size_t)(h * 64 + in) * 64 + out], 0.f) & 0xffffu);
    }
}

template <int MODE>
__device__ __forceinline__ void phase_norm(const float* xin, const float* g, const float* sh, const float* sc, bf16_t* hb, float* outf) {
    const int lane = threadIdx.x & 63, wave = threadIdx.x >> 6;
    const int gw = blockIdx.x * NWAVES + wave, NGW = gridDim.x * NWAVES, rpw = (T + NGW - 1) / NGW;
    f32x4 fv[4][2], sv[4][2];
    int curb = -1;
    for (int i = 0; i < rpw; ++i) {
        const int row = gw * rpw + i; if (row >= T) break;
        const int b = row >> 14;
        if (b != curb) { curb = b;
#pragma unroll
            for (int j = 0; j < 4; ++j)
#pragma unroll
                for (int q = 0; q < 2; ++q) { const int k = (j * 64 + lane) * 8 + q * 4; const f32x4 gg = *(const f32x4*)(g + k);
                    if (MODE == 0) { const f32x4 s = *(const f32x4*)(sc + (size_t)b * NMOD + k); fv[j][q] = gg * (1.0f + s); sv[j][q] = *(const f32x4*)(sh + (size_t)b * NMOD + k); }
                    else { fv[j][q] = gg; sv[j][q] = (f32x4){0.f, 0.f, 0.f, 0.f}; } } }
        const float* xr = xin + (size_t)row * Dm;
        f32x4 v[4][2]; float ss = 0.f;
#pragma unroll
        for (int j = 0; j < 4; ++j)
#pragma unroll
            for (int q = 0; q < 2; ++q) { v[j][q] = *(const f32x4*)(xr + (j * 64 + lane) * 8 + q * 4); const f32x4 t = v[j][q] * v[j][q]; ss += (t[0] + t[1]) + (t[2] + t[3]); }
        ss = wave_sum(ss);
        const float rstd = 1.0f / sqrtf(ss * (1.0f / Dm) + EPS);
#pragma unroll
        for (int j = 0; j < 4; ++j) {
            const f32x4 o0 = v[j][0] * rstd * fv[j][0] + sv[j][0], o1 = v[j][1] * rstd * fv[j][1] + sv[j][1];
            if (MODE == 0) { u32x4 w; w.x = cvt_pk_bf16(o0[0], o0[1]); w.y = cvt_pk_bf16(o0[2], o0[3]); w.z = cvt_pk_bf16(o1[0], o1[1]); w.w = cvt_pk_bf16(o1[2], o1[3]);
                *(u32x4*)(hb + (size_t)row * Dm + (j * 64 + lane) * 8) = w; }
            else { float* op = outf + (size_t)row * Dm + (j * 64 + lane) * 8; *(f32x4*)op = o0; *(f32x4*)(op + 4) = o1; }
        }
    }
}

template <int CTRL> __device__ __forceinline__ float dppf(float oldv, float v) {
    return __builtin_bit_cast(float, __builtin_amdgcn_update_dpp(__builtin_bit_cast(int, oldv), __builtin_bit_cast(int, v), CTRL, 0xf, 0xf, false));
}
constexpr int LMT = 2;
template <bool FINAL>
__device__ __forceinline__ void lru_item(const Params& p, LAS float* tile  , int item) {
    const int lane = threadIdx.x & 63, fr = lane & 15, fq = lane >> 4;
    const int c = item & (NCH - 1), mg0 = ((item >> 6) & 1) * LMT, h = (item >> 7) & 15, b = item >> 11;
    const size_t rowbase = (size_t)b * SEQ;
    const int cch = h * 64 + 4 * fr;
    const f32x4 cw0 = *(const f32x4*)(p.w_conv + 0 * DLRU + cch), cw1 = *(const f32x4*)(p.w_conv + 1 * DLRU + cch), cw2 = *(const f32x4*)(p.w_conv + 2 * DLRU + cch), cw3 = *(const f32x4*)(p.w_conv + 3 * DLRU + cch);
    const f32x4 cbv = *(const f32x4*)(p.b_conv + cch);
    f32x4 ba[LMT], bi[LMT], cl[LMT];
    bf16x8 wa[LMT][2], wi[LMT][2];
#pragma unroll
    for (int mt = 0; mt < LMT; ++mt) { const int ch = h * 64 + (mg0 + mt) * 16 + fq * 4;
        ba[mt] = *(const f32x4*)(p.b_rg_a + ch); bi[mt] = *(const f32x4*)(p.b_rg_i + ch);
        const f32x4 lm = *(const f32x4*)(p.lam + ch);
#pragma unroll
        for (int j = 0; j < 4; ++j) { const float xl = lm[j]; cl[mt][j] = 8.0f * (fminf(xl, 0.f) - log1pf(expf(-fabsf(xl)))); }
#pragma unroll
        for (int ks = 0; ks < 2; ++ks) {
            wa[mt][ks] = *(const bf16x8*)(p.WAf + ((size_t)(((0 * 16 + h) * 4 + mg0 + mt) * 2 + ks) * 64 + lane) * 8);
            wi[mt][ks] = *(const bf16x8*)(p.WAf + ((size_t)(((1 * 16 + h) * 4 + mg0 + mt) * 2 + ks) * 64 + lane) * 8); } }
    f32x4 st0[LMT], st1[LMT];
#pragma unroll
    for (int mt = 0; mt < LMT; ++mt) { st0[mt] = (f32x4){0.f, 0.f, 0.f, 0.f}; st1[mt] = (f32x4){1.f, 1.f, 1.f, 1.f}; }
    if (FINAL) {
        float hin = 0.f; const int ch = h * 64 + lane;
        for (int cc = 0; cc < c; ++cc) { const size_t o = ((size_t)(b * NCH + cc)) * DLRU + ch; hin = p.aggP[o] * hin + p.aggE[o]; }
#pragma unroll
        for (int mt = 0; mt < LMT; ++mt)
#pragma unroll
            for (int j = 0; j < 4; ++j) st0[mt][j] = __shfl(hin, (mg0 + mt) * 16 + fq * 4 + j);
    }
#pragma unroll 1
    for (int nt = 0; nt < TC / 16; ++nt) {
        const int t0 = c * TC + nt * 16;
        f32x4 xv[7];
#pragma unroll
        for (int i = 0; i < 7; ++i) { const int tk = t0 + 4 * fq - 3 + i;
            if (tk >= 0) { const u32x2 w = *(const u32x2*)(p.proj + (rowbase + tk) * NPROJ + cch); xv[i] = (f32x4){bf_lo(w.x), bf_hi(w.x), bf_lo(w.y), bf_hi(w.y)}; }
            else xv[i] = (f32x4){0.f, 0.f, 0.f, 0.f}; }
        asm volatile("" ::: "memory"); __builtin_amdgcn_wave_barrier();
#pragma unroll
        for (int j = 0; j < 4; ++j) { const f32x4 xc = cbv + cw0 * xv[j] + cw1 * xv[j + 1] + cw2 * xv[j + 2] + cw3 * xv[j + 3];
            *(LAS f32x4*)(tile + (4 * fq + j) * 68 + 4 * fr) = xc; }
        asm volatile("" ::: "memory"); __builtin_amdgcn_wave_barrier();
        bf16x8 bfr[2]; f32x4 xd[LMT];
#pragma unroll
        for (int ks = 0; ks < 2; ++ks) { const f32x4 lo = *(const LAS f32x4*)(tile + fr * 68 + ks * 32 + fq * 8), hi = *(const LAS f32x4*)(tile + fr * 68 + ks * 32 + fq * 8 + 4);
            u32x4 w; w.x = cvt_pk_bf16(lo[0], lo[1]); w.y = cvt_pk_bf16(lo[2], lo[3]); w.z = cvt_pk_bf16(hi[0], hi[1]); w.w = cvt_pk_bf16(hi[2], hi[3]);
            bfr[ks] = __builtin_bit_cast(bf16x8, w); }
#pragma unroll
        for (int mt = 0; mt < LMT; ++mt) xd[mt] = *(const LAS f32x4*)(tile + fr * 68 + (mg0 + mt) * 16 + fq * 4);
        asm volatile("" ::: "memory"); __builtin_amdgcn_wave_barrier();
        const size_t trow = rowbase + t0 + fr;
#pragma unroll
        for (int mt = 0; mt < LMT; ++mt) {
            f32x4 dr = (f32x4){0.f, 0.f, 0.f, 0.f}, di = dr;
            dr = __builtin_amdgcn_mfma_f32_16x16x32_bf16(wa[mt][0], bfr[0], dr, 0, 0, 0); dr = __builtin_amdgcn_mfma_f32_16x16x32_bf16(wa[mt][1], bfr[1], dr, 0, 0, 0);
            di = __builtin_amdgcn_mfma_f32_16x16x32_bf16(wi[mt][0], bfr[0], di, 0, 0, 0); di = __builtin_amdgcn_mfma_f32_16x16x32_bf16(wi[mt][1], bfr[1], di, 0, 0, 0);
            f32x4 av, uv;
#pragma unroll
            for (int j = 0; j < 4; ++j) {
                const float r = fast_sigmoid(dr[j] + ba[mt][j]), ig = fast_sigmoid(di[j] + bi[mt][j]);
                float a = __builtin_amdgcn_exp2f(LOG2E * r * cl[mt][j]);
                float u = sqrtf(fmaxf(1.0f - a * a, 0.f)) * ig * xd[mt][j];
                float ap, up;
                ap = dppf<0x111>(1.f, a); up = dppf<0x111>(0.f, u); u = fmaf(a, up, u); a *= ap;
                ap = dppf<0x112>(1.f, a); up = dppf<0x112>(0.f, u); u = fmaf(a, up, u); a *= ap;
                ap = dppf<0x114>(1.f, a); up = dppf<0x114>(0.f, u); u = fmaf(a, up, u); a *= ap;
                ap = dppf<0x118>(1.f, a); up = dppf<0x118>(0.f, u); u = fmaf(a, up, u); a *= ap;
                av[j] = a; uv[j] = u;
            }
            if (FINAL) {
                const int ch = h * 64 + (mg0 + mt) * 16 + fq * 4;
                const u32x2 gw = *(const u32x2*)(p.proj + trow * NPROJ + DLRU + ch);
                const f32x4 gg = (f32x4){bf_lo(gw.x), bf_hi(gw.x), bf_lo(gw.y), bf_hi(gw.y)};
                f32x4 y;
#pragma unroll
                for (int j = 0; j < 4; ++j) { const float hh = fmaf(av[j], st0[mt][j], uv[j]);
                    st0[mt][j] = __shfl(hh, lane | 15);
                    const float gx = gg[j]; const float ge = gx * fast_sigmoid(1.5957691216057308f * (gx + 0.044715f * gx * gx * gx));
                    y[j] = hh * ge; }
                u32x2 w; w.x = cvt_pk_bf16(y[0], y[1]); w.y = cvt_pk_bf16(y[2], y[3]);
                *(u32x2*)(p.ycat + trow * Dm + ch) = w;
            } else {
#pragma unroll
                for (int j = 0; j < 4; ++j) { st0[mt][j] = fmaf(av[j], st0[mt][j], uv[j]); st1[mt][j] *= av[j]; }
            }
        }
    }
    if (!FINAL && fr == 15) {
#pragma unroll
        for (int mt = 0; mt < LMT; ++mt) { const size_t o = ((size_t)(b * NCH + c)) * DLRU + h * 64 + (mg0 + mt) * 16 + fq * 4;
            *(f32x4*)(p.aggE + o) = st0[mt]; *(f32x4*)(p.aggP + o) = st1[mt]; }
    }
}
__device__ __forceinline__ void pool_items(const Params& p) {
    const int lane = threadIdx.x & 63, wave = threadIdx.x >> 6;
    const int gw = blockIdx.x * NWAVES + wave, NGW = gridDim.x * NWAVES;
    for (int item = gw; item < NB * (SEQ / 2) * 4; item += NGW) {
        const int gidx = item & 3, tp = (item >> 2) & (SEQ / 2 - 1), b = item >> 15;
        const int t = 2 * tp + (lane >> 5), w = 2 << gidx, col = 2 * DLRU + gidx * 256 + (lane & 31) * 8;
        const bf16_t* base = p.proj + ((size_t)b * SEQ) * NPROJ + col;
        float s[8], x0[8];
#pragma unroll
        for (int e = 0; e < 8; ++e) s[e] = 0.f;
        for (int q = 0; q < w; ++q) { const int tk = t - q;
            if (tk >= 0) { const u32x4 v = *(const u32x4*)(base + (size_t)tk * NPROJ);
                const float f[8] = {bf_lo(v.x), bf_hi(v.x), bf_lo(v.y), bf_hi(v.y), bf_lo(v.z), bf_hi(v.z), bf_lo(v.w), bf_hi(v.w)};
#pragma unroll
                for (int e = 0; e < 8; ++e) { s[e] += f[e]; if (q == 0) x0[e] = f[e]; } } }
        const float inv = 1.0f / (float)(t + 1 < w ? t + 1 : w);
        u32x4 o; o.x = cvt_pk_bf16(s[0] * inv - x0[0], s[1] * inv - x0[1]); o.y = cvt_pk_bf16(s[2] * inv - x0[2], s[3] * inv - x0[3]);
        o.z = cvt_pk_bf16(s[4] * inv - x0[4], s[5] * inv - x0[5]); o.w = cvt_pk_bf16(s[6] * inv - x0[6], s[7] * inv - x0[7]);
        *(u32x4*)(p.pooled + ((size_t)b * SEQ + t) * DLRU + gidx * 256 + (lane & 31) * 8) = o;
    }
}

constexpr int NPHASE = 10;
#ifndef PHMASK
#define PHMASK 0x3ff
#endif
#define PH_ON(k) (((PHMASK) >> (k)) & 1)
#define SYNC_BEFORE(k) if (ph_lo < (k) && (k) < ph_hi) grid.sync();
__global__ void __launch_bounds__(NTHREADS, 2) fwd_megakernel(Params p, int ph_lo, int ph_hi) {
    extern __shared__ __attribute__((aligned(16))) unsigned char shm[];
    LAS unsigned char* lds = (LAS unsigned char*)shm;
    cg::grid_group grid = cg::this_grid();
    const int G = gridDim.x, wave = threadIdx.x >> 6;
    SYNC_BEFORE(0)
    if (PH_ON(0) && ph_lo <= 0 && 0 < ph_hi) { phase0(p, (LAS float*)lds); }
    SYNC_BEFORE(1)
    if (PH_ON(1) && ph_lo <= 1 && 1 < ph_hi) { phase_norm<0>(p.x, p.g_mix, p.mod + 0 * Dm, p.mod + 1 * Dm, p.HB, nullptr); }
    SYNC_BEFORE(2)
    if (PH_ON(2) && ph_lo <= 2 && 2 < ph_hi) { pg8::Gemm g{p.HB, p.WinT, T, NPROJ, Dm, Dm, Dm, 0}; pg8::StaticOrder S; S.init(T, NPROJ, G, blockIdx.x); pg8::EpiBf16 E{p.proj, NPROJ};
            pg8::gemm_phase<pg8::EpiBf16, pg8::StaticOrder>(lds, g, S, E); }
    SYNC_BEFORE(3)
    if (PH_ON(3) && ph_lo <= 3 && 3 < ph_hi) {
            for (int item = blockIdx.x * NWAVES + wave; item < NB * 16 * (4 / LMT) * NCH; item += G * NWAVES) lru_item<false>(p, (LAS float*)lds + wave * (16 * 68), item);
            pool_items(p); }
    SYNC_BEFORE(4)
    if (PH_ON(4) && ph_lo <= 4 && 4 < ph_hi) {
            for (int item = blockIdx.x * NWAVES + wave; item < NB * 16 * (4 / LMT) * NCH; item += G * NWAVES) lru_item<true>(p, (LAS float*)lds + wave * (16 * 68), item);
            __syncthreads();
            pg8::Gemm g{p.pooled, p.WpT, T, DLRU, 256, DLRU, 256, 512}; pg8::StaticOrder S; S.init(T, DLRU, G, blockIdx.x); pg8::EpiBf16 E{p.ycat + DLRU, Dm};
            pg8::gemm_phase<pg8::EpiBf16, pg8::StaticOrder>(lds, g, S, E); }
    SYNC_BEFORE(5)
    if (PH_ON(5) && ph_lo <= 5 && 5 < ph_hi) { pg8::Gemm g{p.ycat, p.WoutT, T, Dm, Dm, Dm, Dm, 0}; pg8::StaticOrder S; S.init(T, Dm, G, blockIdx.x); pg8::EpiResid E{p.x1, p.x, p.mod + 2 * Dm};
            pg8::gemm_phase<pg8::EpiResid, pg8::StaticOrder>(lds, g, S, E); }
    SYNC_BEFORE(6)
    if (PH_ON(6) && ph_lo <= 6 && 6 < ph_hi) { phase_norm<0>(p.x1, p.g_ffn, p.mod + 3 * Dm, p.mod + 4 * Dm, p.HB, nullptr); }
    SYNC_BEFORE(7)
    if (PH_ON(7) && ph_lo <= 7 && 7 < ph_hi) { pg8::Gemm g{p.HB, p.WguT, T, NGU, Dm, Dm, Dm, 0}; pg8::StaticOrder S; S.init(T, NGU, G, blockIdx.x); pg8::EpiSwiglu E{p.act};
            pg8::gemm_phase<pg8::EpiSwiglu, pg8::StaticOrder>(lds, g, S, E); }
    SYNC_BEFORE(8)
    if (PH_ON(8) && ph_lo <= 8 && 8 < ph_hi) { pg8::Gemm g{p.act, p.WdT, T, Dm, DFF, DFF, DFF, 0}; pg8::StaticOrder S; S.init(T, Dm, G, blockIdx.x); pg8::EpiResid E{p.out, p.x1, p.mod + 5 * Dm};
            pg8::gemm_phase<pg8::EpiResid, pg8::StaticOrder>(lds, g, S, E); }
    SYNC_BEFORE(9)
    if (PH_ON(9) && ph_lo <= 9 && 9 < ph_hi) { phase_norm<1>(p.out, p.g_final, nullptr, nullptr, nullptr, p.out); }
}

extern "C" void kernel_launch(void* const* d_in, const int* in_sizes, int n_in, void* d_out, int out_size, void* d_ws, size_t ws_size, hipStream_t stream) {
    constexpr size_t LDS_BYTES = pg8::STAGE_BYTES;
    static int grid_blocks = 0;
    if (!grid_blocks) {
        int dev = 0, cus = 0, per_cu = 0;
        hipGetDevice(&dev);
        hipDeviceGetAttribute(&cus, hipDeviceAttributeMultiprocessorCount, dev);
        hipFuncSetAttribute((const void*)fwd_megakernel, hipFuncAttributeMaxDynamicSharedMemorySize, (int)LDS_BYTES);
        hipOccupancyMaxActiveBlocksPerMultiprocessor(&per_cu, (const void*)fwd_megakernel, NTHREADS, LDS_BYTES);
        if (per_cu < 1) per_cu = 1;
        if (cus < 1) cus = 256;
        grid_blocks = cus * per_cu;
    }
    Params p{};
    const float* const* in = (const float* const*)d_in;
    p.x = in[0]; p.c = in[1]; p.w_ada = in[2]; p.b_ada = in[3]; p.g_mix = in[4]; p.w_in = in[5]; p.w_conv = in[6]; p.b_conv = in[7];
    p.w_rg_a = in[8]; p.b_rg_a = in[9]; p.w_rg_i = in[10]; p.b_rg_i = in[11]; p.lam = in[12]; p.w_pool = in[13]; p.ls_pool = in[14];
    p.w_out = in[15]; p.g_ffn = in[16]; p.w_gate = in[17]; p.w_up = in[18]; p.w_down = in[19]; p.g_final = in[20];
    p.out = (float*)d_out;
    unsigned char* ws = (unsigned char*)d_ws; size_t off = 0;
    auto take = [&](size_t bytes) { unsigned char* r = ws + off; off += (bytes + 255) & ~(size_t)255; return r; };
    p.WinT = (bf16_t*)take((size_t)NPROJ * Dm * 2);
    p.WoutT = (bf16_t*)take((size_t)Dm * Dm * 2);
    p.WguT = (bf16_t*)take((size_t)NGU * Dm * 2);
    p.WdT = (bf16_t*)take((size_t)Dm * DFF * 2);
    p.WpT = (bf16_t*)take((size_t)DLRU * 256 * 2);
    p.WAf = (bf16_t*)take((size_t)2 * 16 * 4096 * 2);
    p.mod = (float*)take((size_t)NB * NMOD * 4);
    p.aggP = (float*)take((size_t)NB * NCH * DLRU * 4);
    p.aggE = (float*)take((size_t)NB * NCH * DLRU * 4);
    p.HB = (bf16_t*)take((size_t)T * Dm * 2);
    p.x1 = (float*)take((size_t)T * Dm * 4);
    unsigned char* r1 = take(0);
    p.proj = (bf16_t*)take((size_t)T * NPROJ * 2);
    p.pooled = (bf16_t*)take((size_t)T * DLRU * 2);
    p.ycat = (bf16_t*)take((size_t)T * Dm * 2);
    p.act = (bf16_t*)r1;
    int ph_lo = 0, ph_hi = NPHASE;
    void* args[] = {&p, &ph_lo, &ph_hi};
    hipError_t e = hipLaunchCooperativeKernel((const void*)fwd_megakernel, dim3(grid_blocks), dim3(NTHREADS), args, (unsigned)LDS_BYTES, stream);
    if (e != hipSuccess) fprintf(stderr, "cooperative launch failed: %s (grid %d)\n", hipGetErrorString(e), grid_blocks);
}
```

```cpp
#include <hip/hip_runtime.h>
#include <hip/hip_cooperative_groups.h>
#include <cstdio>
#include <cstdint>
namespace cg = cooperative_groups;

#define LAS __attribute__((address_space(3)))
typedef unsigned short bf16_t;
typedef short bf16x8 __attribute__((ext_vector_type(8)));
typedef float f32x4 __attribute__((ext_vector_type(4)));
typedef unsigned u32x4 __attribute__((ext_vector_type(4)));
typedef unsigned u32x2 __attribute__((ext_vector_type(2)));

constexpr int Dm = 2048, NB = 2, SEQ = 16384, T = NB * SEQ, DLRU = 1024, NPROJ = 3072, DFF = 5632, NGU = 2 * DFF, NMOD = 6 * Dm;
constexpr int TC = 256, NCH = SEQ / TC;
constexpr int NTHREADS = 512, NWAVES = 8;
constexpr float EPS = 1e-6f;
constexpr float LOG2E = 1.4426950408889634f;

struct Params {
    const float *x, *c, *w_ada, *b_ada, *g_mix, *w_in, *w_conv, *b_conv, *w_rg_a, *b_rg_a, *w_rg_i, *b_rg_i, *lam, *w_pool, *ls_pool, *w_out, *g_ffn, *w_gate, *w_up, *w_down, *g_final;
    float* out;
    bf16_t *WinT, *WoutT, *WguT, *WdT, *WpT, *WAf;
    float *mod, *aggP, *aggE;
    bf16_t *HB, *proj, *pooled, *ycat, *act;
    float* x1;
};

__device__ __forceinline__ unsigned cvt_pk_bf16(float lo, float hi) { unsigned r; asm("v_cvt_pk_bf16_f32 %0, %1, %2" : "=v"(r) : "v"(lo), "v"(hi)); return r; }
__device__ __forceinline__ float bf_lo(unsigned w) { return __uint_as_float(w << 16); }
__device__ __forceinline__ float bf_hi(unsigned w) { return __uint_as_float(w & 0xffff0000u); }
__device__ __forceinline__ float fast_sigmoid(float v) { return __builtin_amdgcn_rcpf(1.0f + __builtin_amdgcn_exp2f(-LOG2E * v)); }
__device__ __forceinline__ float wave_sum(float v) {
#pragma unroll
    for (int o = 1; o < 64; o <<= 1) v += __shfl_xor(v, o);
    return v;
}

namespace pg8 {
constexpr int BM = 256, BK = 64, HALF = 128, HTB = HALF * BK * 2  , STAGE_BYTES = 8 * HTB, NXCD = 8, WGM = 8;

__host__ __device__ __forceinline__ int lds_byte(int r, int c) { const int st = (r >> 4) * 2 + (c >> 5), rr = r & 15, cc = c & 31, ob = rr * 64 + cc * 2; return st * 1024 + (ob ^ (((ob >> 9) & 1) << 5)); }
__host__ __device__ __forceinline__ void stage_rc(int b, int& R, int& C) { const int st = b / 1024, sb = b % 1024, swz = sb ^ (((sb >> 9) & 1) << 5); R = (st >> 1) * 16 + swz / 64; C = (st & 1) * 32 + (swz % 64) / 2; }
__host__ __device__ __forceinline__ int perm32(int rho) { const int n = rho >> 4, i = rho & 15; return 8 * (i >> 2) + 4 * n + (i & 3); }

struct Unit { int pm, pn; };
struct Gemm { const bf16_t* A; const bf16_t* Bt; int M, N, K, lda, ldb, a_pn_off; };

struct StaticOrder {
    int nM, nN, nwg, G, c;
    __host__ __device__ void init(int M, int N, int G_, int c_) { nM = M / BM; nN = N / BM; nwg = nM * nN; G = G_; c = c_; }
    __host__ __device__ bool next(int i, Unit& u) const {
        const long L = (long)i * G + c; if (L >= nwg) return false;
        int wgid = (int)L; { const int q = nwg / NXCD, r = nwg % NXCD, xcd = wgid % NXCD, off = wgid / NXCD; wgid = (xcd < r ? xcd * (q + 1) : r * (q + 1) + (xcd - r) * q) + off; }
        const int nig = WGM * nN, gid = wgid / nig, fm = gid * WGM, gsz = (nM - fm) < WGM ? (nM - fm) : WGM;
        u.pm = fm + ((wgid % nig) % gsz); u.pn = (wgid % nig) / gsz; return true;
    }
};

struct EpiBf16 {
    static constexpr bool PERM = true;
    bf16_t* O; int ldc;
    __device__ __forceinline__ void operator()(const f32x4 (&acc)[2][2][4][2], const Unit& u, int wr, int wc, int fr, int fq) const {
        const int row0 = u.pm * BM + wr * 64 + fr, col0 = u.pn * BM + wc * 32 + 8 * fq;
#pragma unroll
        for (int ai = 0; ai < 2; ++ai)
#pragma unroll
            for (int m = 0; m < 4; ++m) { bf16_t* rowp = O + (size_t)(row0 + ai * HALF + m * 16) * ldc + col0;
#pragma unroll
                for (int bj = 0; bj < 2; ++bj) { const f32x4 v0 = acc[ai][bj][m][0], v1 = acc[ai][bj][m][1];
                    u32x4 w; w.x = cvt_pk_bf16(v0[0], v0[1]); w.y = cvt_pk_bf16(v0[2], v0[3]); w.z = cvt_pk_bf16(v1[0], v1[1]); w.w = cvt_pk_bf16(v1[2], v1[3]);
                    *(u32x4*)(rowp + bj * HALF) = w; } }
    }
};
struct EpiResid {
    static constexpr bool PERM = false;
    float* out; const float* base; const float* gate;
    __device__ __forceinline__ void operator()(const f32x4 (&acc)[2][2][4][2], const Unit& u, int wr, int wc, int fr, int fq) const {
        const int row0 = u.pm * BM + wr * 64 + fr, col0 = u.pn * BM + wc * 32 + 4 * fq;
        const float* gp = gate + (size_t)(u.pm >> 6) * NMOD + col0;
        f32x4 gv[2][2];
#pragma unroll
        for (int bj = 0; bj < 2; ++bj)
#pragma unroll
            for (int n = 0; n < 2; ++n) gv[bj][n] = *(const f32x4*)(gp + bj * HALF + n * 16);
#pragma unroll
        for (int ai = 0; ai < 2; ++ai)
#pragma unroll
            for (int m = 0; m < 4; ++m) { const size_t ro = (size_t)(row0 + ai * HALF + m * 16) * Dm + col0;
#pragma unroll
                for (int bj = 0; bj < 2; ++bj)
#pragma unroll
                    for (int n = 0; n < 2; ++n) { const f32x4 bv = *(const f32x4*)(base + ro + bj * HALF + n * 16);
                        *(f32x4*)(out + ro + bj * HALF + n * 16) = bv + gv[bj][n] * acc[ai][bj][m][n]; } }
    }
};
struct EpiSwiglu {
    static constexpr bool PERM = true;
    bf16_t* O;
    __device__ __forceinline__ void operator()(const f32x4 (&acc)[2][2][4][2], const Unit& u, int wr, int wc, int fr, int fq) const {
        const int row0 = u.pm * BM + wr * 64 + fr, col0 = u.pn * HALF + wc * 32 + 8 * fq;
#pragma unroll
        for (int ai = 0; ai < 2; ++ai)
#pragma unroll
            for (int m = 0; m < 4; ++m) { bf16_t* rowp = O + (size_t)(row0 + ai * HALF + m * 16) * DFF + col0;
                f32x4 v0, v1;
#pragma unroll
                for (int j = 0; j < 4; ++j) { const float g0 = acc[ai][0][m][0][j], g1 = acc[ai][0][m][1][j];
                    v0[j] = g0 * fast_sigmoid(g0) * acc[ai][1][m][0][j]; v1[j] = g1 * fast_sigmoid(g1) * acc[ai][1][m][1][j]; }
                u32x4 w; w.x = cvt_pk_bf16(v0[0], v0[1]); w.y = cvt_pk_bf16(v0[2], v0[3]); w.z = cvt_pk_bf16(v1[0], v1[1]); w.w = cvt_pk_bf16(v1[2], v1[3]);
                *(u32x4*)rowp = w; }
    }
};

template <class Epi, class Sched, bool ALIGN_EPI = true>
__device__ __forceinline__ void gemm_phase(LAS unsigned char* lds, const Gemm g, const Sched& S, const Epi& E) {
    const int tid = threadIdx.x, wid = __builtin_amdgcn_readfirstlane(tid >> 6), lane = tid & 63, wr = wid >> 2, wc = wid & 3, fr = lane & 15, fq = lane >> 4;
    const int K = g.K, nt = K / BK;
    unsigned voffA[2], voffB[2];
#pragma unroll
    for (int i = 0; i < 2; ++i) { int R, C; stage_rc(tid * 16 + i * 8192, R, C); const int Rb = Epi::PERM ? ((R & ~31) + perm32(R & 31)) : R;
        voffA[i] = (unsigned)(R * g.lda + C) * 2u; voffB[i] = (unsigned)(Rb * g.ldb + C) * 2u; }
    const size_t kstep = (size_t)(BK * 2);
    const size_t hstepA = (size_t)HALF * g.lda * 2, hstepB = (size_t)HALF * g.ldb * 2;
    const size_t tstepA = 2 * hstepA, tstepB = 2 * hstepB;
    const unsigned ldsw = (unsigned)wid * 1024u;
    const int aoff = lds_byte(wr * 64 + fr, fq * 8), boff = lds_byte(wc * 32 + fr, fq * 8);
#define PG8_SA(b, h) (((b) * 2 + (h)) * HTB)
#define PG8_SB(b, h) ((4 + (b) * 2 + (h)) * HTB)
#define PG8_STAGE(bufoff, gbase, voff) do { _Pragma("unroll") for (int _i = 0; _i < 2; ++_i) \
        __builtin_amdgcn_global_load_lds((const unsigned*)((const char*)(gbase) + (voff)[_i]), (LAS unsigned*)(lds + (bufoff) + ldsw + _i * 8192), 16, 0, 0); } while (0)
#define PG8_LDA(dst, b, h) do { _Pragma("unroll") for (int m = 0; m < 4; ++m) _Pragma("unroll") for (int k = 0; k < 2; ++k) dst[m][k] = *(const LAS bf16x8*)(lds + PG8_SA(b, h) + aoff + m * 2048 + k * 1024); } while (0)
#define PG8_LDB(dst, b, h) do { _Pragma("unroll") for (int n = 0; n < 2; ++n) _Pragma("unroll") for (int k = 0; k < 2; ++k) dst[n][k] = *(const LAS bf16x8*)(lds + PG8_SB(b, h) + boff + n * 2048 + k * 1024); } while (0)
#define PG8_MMA(ai, bj, At, Bt) do { __builtin_amdgcn_s_setprio(1); _Pragma("unroll") for (int m = 0; m < 4; ++m) _Pragma("unroll") for (int n = 0; n < 2; ++n) _Pragma("unroll") for (int k = 0; k < 2; ++k) \
        acc[ai][bj][m][n] = __builtin_amdgcn_mfma_f32_16x16x32_bf16(Bt[n][k], At[m][k], acc[ai][bj][m][n], 0, 0, 0); __builtin_amdgcn_s_setprio(0); } while (0)
#define PG8_WAIT_V(n) asm volatile("s_waitcnt vmcnt(" #n ")" ::: "memory")
#define PG8_WAIT_L(n) asm volatile("s_waitcnt lgkmcnt(" #n ")" ::: "memory")
#define PG8_BAR __builtin_amdgcn_s_barrier()
#define PG8_SCHED __builtin_amdgcn_sched_barrier(0)
    Unit cur, nxt; int ui = 0;
    if (!S.next(0, cur)) return;
    f32x4 acc[2][2][4][2];
#pragma unroll
    for (int a = 0; a < 2; ++a)
#pragma unroll
        for (int b = 0; b < 2; ++b)
#pragma unroll
            for (int m = 0; m < 4; ++m)
#pragma unroll
                for (int n = 0; n < 2; ++n) acc[a][b][m][n] = (f32x4){0.f, 0.f, 0.f, 0.f};
    bf16x8 At[4][2], B0[2][2], B1[2][2];
    const char* cA = (const char*)g.A + (size_t)cur.pm * tstepA + (size_t)cur.pn * g.a_pn_off; const char* cB = (const char*)g.Bt + (size_t)cur.pn * tstepB;
    PG8_STAGE(PG8_SB(0, 0), cB, voffB); PG8_STAGE(PG8_SB(0, 1), cB + hstepB, voffB); PG8_STAGE(PG8_SA(0, 0), cA, voffA); PG8_STAGE(PG8_SA(0, 1), cA + hstepA, voffA);
    if (wr == 1) PG8_BAR;
    PG8_WAIT_V(2); PG8_BAR;
    PG8_STAGE(PG8_SB(1, 0), cB + kstep, voffB); PG8_STAGE(PG8_SA(1, 0), cA + kstep, voffA); PG8_STAGE(PG8_SB(1, 1), cB + hstepB + kstep, voffB);
    PG8_WAIT_V(6); PG8_BAR;
    for (;;) {
        const bool has_next = S.next(ui + 1, nxt);
        const char* nA = has_next ? (const char*)g.A + (size_t)nxt.pm * tstepA + (size_t)nxt.pn * g.a_pn_off : cA; const char* nB = has_next ? (const char*)g.Bt + (size_t)nxt.pn * tstepB : cB;
        for (int t = 0; t < nt; t += 2) {
            const bool last = (t == nt - 2);
            const char* a1 = cA + (size_t)(t + 1) * kstep;
            const char* a2 = last ? nA : cA + (size_t)(t + 2) * kstep; const char* b2 = last ? nB : cB + (size_t)(t + 2) * kstep;
            const char* a3 = a2 + kstep; const char* b3 = b2 + kstep;
            PG8_LDB(B0, 0, 0); PG8_LDB(B1, 0, 1); PG8_SCHED; PG8_LDA(At, 0, 0); PG8_STAGE(PG8_SA(1, 1), a1 + hstepA, voffA);
            PG8_WAIT_V(8); PG8_WAIT_L(0); PG8_BAR; PG8_MMA(0, 0, At, B0); PG8_MMA(0, 1, At, B1); PG8_BAR; PG8_SCHED;
            PG8_LDA(At, 0, 1); PG8_STAGE(PG8_SB(0, 0), b2, voffB); PG8_STAGE(PG8_SB(0, 1), b2 + hstepB, voffB); PG8_STAGE(PG8_SA(0, 0), a2, voffA);
            PG8_WAIT_V(8); PG8_WAIT_L(0); PG8_BAR; PG8_MMA(1, 0, At, B0); PG8_MMA(1, 1, At, B1); PG8_BAR; PG8_SCHED;
            PG8_LDB(B0, 1, 0); PG8_LDB(B1, 1, 1); PG8_SCHED; PG8_LDA(At, 1, 0); PG8_STAGE(PG8_SA(0, 1), a2 + hstepA, voffA);
            PG8_WAIT_V(8); PG8_WAIT_L(0); PG8_BAR; PG8_MMA(0, 0, At, B0); PG8_MMA(0, 1, At, B1); PG8_BAR; PG8_SCHED;
            PG8_LDA(At, 1, 1); PG8_STAGE(PG8_SB(1, 0), b3, voffB); PG8_STAGE(PG8_SB(1, 1), b3 + hstepB, voffB); PG8_STAGE(PG8_SA(1, 0), a3, voffA);
            PG8_WAIT_V(8); PG8_WAIT_L(0); PG8_BAR; PG8_MMA(1, 0, At, B0); PG8_MMA(1, 1, At, B1); PG8_BAR; PG8_SCHED;
        }
        if constexpr (ALIGN_EPI) { if (wr == 0) PG8_BAR; }
        E(acc, cur, wr, wc, fr, fq);
        if (!has_next) break;
#pragma unroll
        for (int a = 0; a < 2; ++a)
#pragma unroll
            for (int b = 0; b < 2; ++b)
#pragma unroll
                for (int m = 0; m < 4; ++m)
#pragma unroll
                    for (int n = 0; n < 2; ++n) acc[a][b][m][n] = (f32x4){0.f, 0.f, 0.f, 0.f};
        cur = nxt; cA = nA; cB = nB; ++ui;
        if constexpr (ALIGN_EPI) { if (wr == 1) PG8_BAR; }
    }
    PG8_WAIT_V(0);
    if constexpr (!ALIGN_EPI) { if (wr == 0) PG8_BAR; }
    PG8_BAR;
#undef PG8_SA
#undef PG8_SB
#undef PG8_STAGE
#undef PG8_LDA
#undef PG8_LDB
#undef PG8_MMA
#undef PG8_WAIT_V
#undef PG8_WAIT_L
#undef PG8_BAR
#undef PG8_SCHED
}
}

__device__ __forceinline__ void mod_task(const Params& p, LAS float* lds, int jg) {
    const int tid = threadIdx.x;
    LAS float* sc = lds;
    LAS float* red = lds + 4096;
    for (int i = tid; i < NB * Dm; i += NTHREADS) { const float v = p.c[i]; sc[i] = v * fast_sigmoid(v); }
    __syncthreads();
    const int c4 = tid & 31, ks = tid >> 5;
    const float* wp = p.w_ada + (size_t)(ks * 128) * NMOD + jg * 128 + c4 * 4;
    f32x4 a0 = (f32x4){0.f, 0.f, 0.f, 0.f}, a1 = a0;
#pragma unroll 8
    for (int kk = 0; kk < 128; ++kk) {
        const f32x4 w = *(const f32x4*)(wp + (size_t)kk * NMOD);
        const float s0 = sc[ks * 128 + kk], s1 = sc[Dm + ks * 128 + kk];
        a0 += s0 * w; a1 += s1 * w;
    }
    *(LAS f32x4*)(red + (ks * 2 + 0) * 128 + c4 * 4) = a0;
    *(LAS f32x4*)(red + (ks * 2 + 1) * 128 + c4 * 4) = a1;
    __syncthreads();
    if (tid < 256) { const int b = tid >> 7, j = tid & 127; float s = p.b_ada[jg * 128 + j];
#pragma unroll
        for (int k2 = 0; k2 < 16; ++k2) s += red[(k2 * 2 + b) * 128 + j];
        p.mod[(size_t)b * NMOD + jg * 128 + j] = s; }
    __syncthreads();
}
__device__ __forceinline__ void transpose_tile(const float* src, int N, bf16_t* dst, int ldd, int mode, const float* scale, int tile, LAS float* lds) {
    const int tid = threadIdx.x, ntn = N >> 6, kt = tile / ntn, ntile = tile - kt * ntn, k0 = kt * 64, n0 = ntile * 64;
    { const int kr = tid >> 4, n4 = (tid & 15) * 4;
#pragma unroll
      for (int i = 0; i < 2; ++i) { const f32x4 v = *(const f32x4*)(src + (size_t)(k0 + kr + 32 * i) * N + n0 + n4);
          LAS float* d = lds + (kr + 32 * i) * 65 + n4; d[0] = v[0]; d[1] = v[1]; d[2] = v[2]; d[3] = v[3]; } }
    __syncthreads();
    { const int n = tid >> 3, k8 = tid & 7; const LAS float* s = lds + (k8 * 8) * 65 + n; const int nn = n0 + n;
      const float sc = scale ? scale[nn] : 1.0f;
      u32x4 o; o.x = cvt_pk_bf16(s[0] * sc, s[65] * sc); o.y = cvt_pk_bf16(s[2 * 65] * sc, s[3 * 65] * sc); o.z = cvt_pk_bf16(s[4 * 65] * sc, s[5 * 65] * sc); o.w = cvt_pk_bf16(s[6 * 65] * sc, s[7 * 65] * sc);
      const int drow = mode == 0 ? nn : (256 * (nn >> 7) + (nn & 127) + (mode == 2 ? 128 : 0));
      *(u32x4*)(dst + (size_t)drow * ldd + k0 + k8 * 8) = o; }
    __syncthreads();
}
__device__ __forceinline__ void phase0(const Params& p, LAS float* lds) {
    const int G = gridDim.x;
    constexpr int T_MOD = NMOD / 128;
    constexpr int T_IN = (Dm / 64) * (NPROJ / 64), T_OUT = (Dm / 64) * (Dm / 64), T_G = (Dm / 64) * (DFF / 64), T_D = (DFF / 64) * (Dm / 64), T_P = 4 * 16;
    constexpr int NTASK = T_MOD + T_IN + T_OUT + 2 * T_G + T_D + T_P;
    for (int task = blockIdx.x; task < NTASK; task += G) {
        int r = task;
        if (r < T_MOD) { mod_task(p, lds, r); continue; } r -= T_MOD;
        if (r < T_IN) { transpose_tile(p.w_in, NPROJ, p.WinT, Dm, 0, nullptr, r, lds); continue; } r -= T_IN;
        if (r < T_OUT) { transpose_tile(p.w_out, Dm, p.WoutT, Dm, 0, nullptr, r, lds); continue; } r -= T_OUT;
        if (r < T_G) { transpose_tile(p.w_gate, DFF, p.WguT, Dm, 1, nullptr, r, lds); continue; } r -= T_G;
        if (r < T_G) { transpose_tile(p.w_up, DFF, p.WguT, Dm, 2, nullptr, r, lds); continue; } r -= T_G;
        if (r < T_D) { transpose_tile(p.w_down, Dm, p.WdT, DFF, 0, nullptr, r, lds); continue; } r -= T_D;
        { const int gidx = r >> 4; transpose_tile(p.w_pool + (size_t)gidx * 65536, 256, p.WpT + (size_t)gidx * 65536, 256, 0, p.ls_pool + gidx * 256, r & 15, lds); }
    }
    for (int e = blockIdx.x * NTHREADS + threadIdx.x; e < 2 * 16 * 4096; e += G * NTHREADS) {
        const int el = e & 7, ln = (e >> 3) & 63, ks = (e >> 9) & 1, mt = (e >> 10) & 3, h = (e >> 12) & 15, gate = e >> 16;
        const int in = ks * 32 + (ln >> 4) * 8 + el, out = mt * 16 + (ln & 15);
        const float* w = gate ? p.w_rg_i : p.w_rg_a;
        p.WAf[e] = (bf16_t)(cvt_pk_bf16(w[(size_t)(h * 64 + in) * 64 + out], 0.f) & 0xffffu);
    }
}

template <int MODE>
__device__ __forceinline__ void phase_norm(const float* xin, const float* g, const float* sh, const float* sc, bf16_t* hb, float* outf) {
    const int lane = threadIdx.x & 63, wave = threadIdx.x >> 6;
    const int gw = blockIdx.x * NWAVES + wave, NGW = gridDim.x * NWAVES, rpw = (T + NGW - 1) / NGW;
    f32x4 fv[4][2], sv[4][2];
    int curb = -1;
    for (int i = 0; i < rpw; ++i) {
        const int row = gw * rpw + i; if (row >= T) break;
        const int b = row >> 14;
        if (b != curb) { curb = b;
#pragma unroll
            for (int j = 0; j < 4; ++j)
#pragma unroll
                for (int q = 0; q < 2; ++q) { const int k = (j * 64 + lane) * 8 + q * 4; const f32x4 gg = *(const f32x4*)(g + k);
                    if (MODE == 0) { const f32x4 s = *(const f32x4*)(sc + (size_t)b * NMOD + k); fv[j][q] = gg * (1.0f + s); sv[j][q] = *(const f32x4*)(sh + (size_t)b * NMOD + k); }
                    else { fv[j][q] = gg; sv[j][q] = (f32x4){0.f, 0.f, 0.f, 0.f}; } } }
        const float* xr = xin + (size_t)row * Dm;
        f32x4 v[4][2]; float ss = 0.f;
#pragma unroll
        for (int j = 0; j < 4; ++j)
#pragma unroll
            for (int q = 0; q < 2; ++q) { v[j][q] = *(const f32x4*)(xr + (j * 64 + lane) * 8 + q * 4); const f32x4 t = v[j][q] * v[j][q]; ss += (t[0] + t[1]) + (t[2] + t[3]); }
        ss = wave_sum(ss);
        const float rstd = 1.0f / sqrtf(ss * (1.0f / Dm) + EPS);
#pragma unroll
        for (int j = 0; j < 4; ++j) {
            const f32x4 o0 = v[j][0] * rstd * fv[j][0] + sv[j][0], o1 = v[j][1] * rstd * fv[j][1] + sv[j][1];
            if (MODE == 0) { u32x4 w; w.x = cvt_pk_bf16(o0[0], o0[1]); w.y = cvt_pk_bf16(o0[2], o0[3]); w.z = cvt_pk_bf16(o1[0], o1[1]); w.w = cvt_pk_bf16(o1[2], o1[3]);
                *(u32x4*)(hb + (size_t)row * Dm + (j * 64 + lane) * 8) = w; }
            else { float* op = outf + (size_t)row * Dm + (j * 64 + lane) * 8; *(f32x4*)op = o0; *(f32x4*)(op + 4) = o1; }
        }
    }
}

template <int CTRL> __device__ __forceinline__ float dppf(float oldv, float v) {
    return __builtin_bit_cast(float, __builtin_amdgcn_update_dpp(__builtin_bit_cast(int, oldv), __builtin_bit_cast(int, v), CTRL, 0xf, 0xf, false));
}
constexpr int LMT = 2;
template <bool FINAL>
__device__ __forceinline__ void lru_item(const Params& p, LAS float* tile  , int item) {
    const int lane = threadIdx.x & 63, fr = lane & 15, fq = lane >> 4;
    const int c = item & (NCH - 1), mg0 = ((item >> 6) & 1) * LMT, h = (item >> 7) & 15, b = item >> 11;
    const size_t rowbase = (size_t)b * SEQ;
    const int cch = h * 64 + 4 * fr;
    const f32x4 cw0 = *(const f32x4*)(p.w_conv + 0 * DLRU + cch), cw1 = *(const f32x4*)(p.w_conv + 1 * DLRU + cch), cw2 = *(const f32x4*)(p.w_conv + 2 * DLRU + cch), cw3 = *(const f32x4*)(p.w_conv + 3 * DLRU + cch);
    const f32x4 cbv = *(const f32x4*)(p.b_conv + cch);
    f32x4 ba[LMT], bi[LMT], cl[LMT];
    bf16x8 wa[LMT][2], wi[LMT][2];
#pragma unroll
    for (int mt = 0; mt < LMT; ++mt) { const int ch = h * 64 + (mg0 + mt) * 16 + fq * 4;
        ba[mt] = *(const f32x4*)(p.b_rg_a + ch); bi[mt] = *(const f32x4*)(p.b_rg_i + ch);
        const f32x4 lm = *(const f32x4*)(p.lam + ch);
#pragma unroll
        for (int j = 0; j < 4; ++j) { const float xl = lm[j]; cl[mt][j] = (8.0f * LOG2E) * (fminf(xl, 0.f) - log1pf(expf(-fabsf(xl)))); }
#pragma unroll
        for (int ks = 0; ks < 2; ++ks) {
            wa[mt][ks] = *(const bf16x8*)(p.WAf + ((size_t)(((0 * 16 + h) * 4 + mg0 + mt) * 2 + ks) * 64 + lane) * 8);
            wi[mt][ks] = *(const bf16x8*)(p.WAf + ((size_t)(((1 * 16 + h) * 4 + mg0 + mt) * 2 + ks) * 64 + lane) * 8); } }
    f32x4 st0[LMT], st1[LMT];
#pragma unroll
    for (int mt = 0; mt < LMT; ++mt) { st0[mt] = (f32x4){0.f, 0.f, 0.f, 0.f}; st1[mt] = (f32x4){1.f, 1.f, 1.f, 1.f}; }
    u32x2 raw[7]; u32x2 graw[LMT];
    const bf16_t* xsrc = p.proj + (rowbase + (size_t)c * TC) * NPROJ + cch;
    const bf16_t* gsrc = p.proj + (rowbase + (size_t)c * TC + fr) * NPROJ + DLRU + h * 64 + mg0 * 16 + fq * 4;
#pragma unroll
    for (int i = 0; i < 7; ++i) { const int dt = 4 * fq - 3 + i;
        if (c * TC + dt >= 0) raw[i] = *(const u32x2*)(xsrc + (long)dt * NPROJ); else raw[i] = (u32x2){0u, 0u}; }
    if (FINAL) {
#pragma unroll
        for (int mt = 0; mt < LMT; ++mt) graw[mt] = *(const u32x2*)(gsrc + mt * 16);
        float hin = 0.f; const int ch = h * 64 + lane;
        const float* pP = p.aggP + (size_t)(b * NCH) * DLRU + ch; const float* pE = p.aggE + (size_t)(b * NCH) * DLRU + ch;
#pragma unroll 8
        for (int cc = 0; cc < c; ++cc) hin = pP[(size_t)cc * DLRU] * hin + pE[(size_t)cc * DLRU];
#pragma unroll
        for (int mt = 0; mt < LMT; ++mt)
#pragma unroll
            for (int j = 0; j < 4; ++j) st0[mt][j] = __shfl(hin, (mg0 + mt) * 16 + fq * 4 + j);
    }
#pragma unroll 1
    for (int nt = 0; nt < TC / 16; ++nt) {
        f32x4 xv[7];
#pragma unroll
        for (int i = 0; i < 7; ++i) xv[i] = (f32x4){bf_lo(raw[i].x), bf_hi(raw[i].x), bf_lo(raw[i].y), bf_hi(raw[i].y)};
        f32x4 gg[LMT];
        if (FINAL) {
#pragma unroll
            for (int mt = 0; mt < LMT; ++mt) gg[mt] = (f32x4){bf_lo(graw[mt].x), bf_hi(graw[mt].x), bf_lo(graw[mt].y), bf_hi(graw[mt].y)};
        }
        if (nt + 1 < TC / 16) {
            const bf16_t* xn = xsrc + (size_t)(nt + 1) * 16 * NPROJ;
#pragma unroll
            for (int i = 0; i < 7; ++i) raw[i] = *(const u32x2*)(xn + (long)(4 * fq - 3 + i) * NPROJ);
            if (FINAL) {
#pragma unroll
                for (int mt = 0; mt < LMT; ++mt) graw[mt] = *(const u32x2*)(gsrc + (size_t)(nt + 1) * 16 * NPROJ + mt * 16);
            }
        }
        asm volatile("" ::: "memory"); __builtin_amdgcn_wave_barrier();
#pragma unroll
        for (int j = 0; j < 4; ++j) { const f32x4 xc = cbv + cw0 * xv[j] + cw1 * xv[j + 1] + cw2 * xv[j + 2] + cw3 * xv[j + 3];
            *(LAS f32x4*)(tile + (4 * fq + j) * 68 + 4 * fr) = xc; }
        asm volatile("" ::: "memory"); __builtin_amdgcn_wave_barrier();
        bf16x8 bfr[2]; f32x4 xd[LMT];
#pragma unroll
        for (int ks = 0; ks < 2; ++ks) { const f32x4 lo = *(const LAS f32x4*)(tile + fr * 68 + ks * 32 + fq * 8), hi = *(const LAS f32x4*)(tile + fr * 68 + ks * 32 + fq * 8 + 4);
            u32x4 w; w.x = cvt_pk_bf16(lo[0], lo[1]); w.y = cvt_pk_bf16(lo[2], lo[3]); w.z = cvt_pk_bf16(hi[0], hi[1]); w.w = cvt_pk_bf16(hi[2], hi[3]);
            bfr[ks] = __builtin_bit_cast(bf16x8, w); }
#pragma unroll
        for (int mt = 0; mt < LMT; ++mt) xd[mt] = *(const LAS f32x4*)(tile + fr * 68 + (mg0 + mt) * 16 + fq * 4);
        asm volatile("" ::: "memory"); __builtin_amdgcn_wave_barrier();
        const size_t trow = rowbase + (size_t)c * TC + nt * 16 + fr;
#pragma unroll
        for (int mt = 0; mt < LMT; ++mt) {
            f32x4 dr = (f32x4){0.f, 0.f, 0.f, 0.f}, di = dr;
            dr = __builtin_amdgcn_mfma_f32_16x16x32_bf16(wa[mt][0], bfr[0], dr, 0, 0, 0); dr = __builtin_amdgcn_mfma_f32_16x16x32_bf16(wa[mt][1], bfr[1], dr, 0, 0, 0);
            di = __builtin_amdgcn_mfma_f32_16x16x32_bf16(wi[mt][0], bfr[0], di, 0, 0, 0); di = __builtin_amdgcn_mfma_f32_16x16x32_bf16(wi[mt][1], bfr[1], di, 0, 0, 0);
            f32x4 av, uv;
#pragma unroll
            for (int j = 0; j < 4; ++j) {
                const float r = fast_sigmoid(dr[j] + ba[mt][j]), ig = fast_sigmoid(di[j] + bi[mt][j]);
                float a = __builtin_amdgcn_exp2f(r * cl[mt][j]);
                float u = __builtin_amdgcn_sqrtf(1.0f - a * a) * ig * xd[mt][j];
                float ap, up;
                ap = dppf<0x111>(1.f, a); up = dppf<0x111>(0.f, u); u = fmaf(a, up, u); a *= ap;
                ap = dppf<0x112>(1.f, a); up = dppf<0x112>(0.f, u); u = fmaf(a, up, u); a *= ap;
                ap = dppf<0x114>(1.f, a); up = dppf<0x114>(0.f, u); u = fmaf(a, up, u); a *= ap;
                ap = dppf<0x118>(1.f, a); up = dppf<0x118>(0.f, u); u = fmaf(a, up, u); a *= ap;
                av[j] = a; uv[j] = u;
            }
            if (FINAL) {
                const int ch = h * 64 + (mg0 + mt) * 16 + fq * 4;
                f32x4 y;
#pragma unroll
                for (int j = 0; j < 4; ++j) { const float hh = fmaf(av[j], st0[mt][j], uv[j]);
                    st0[mt][j] = __shfl(hh, lane | 15);
                    const float gx = gg[mt][j]; const float ge = gx * fast_sigmoid(1.5957691216057308f * (gx + 0.044715f * gx * gx * gx));
                    y[j] = hh * ge; }
                u32x2 w; w.x = cvt_pk_bf16(y[0], y[1]); w.y = cvt_pk_bf16(y[2], y[3]);
                *(u32x2*)(p.ycat + trow * Dm + ch) = w;
            } else {
#pragma unroll
                for (int j = 0; j < 4; ++j) { st0[mt][j] = fmaf(av[j], st0[mt][j], uv[j]); st1[mt][j] *= av[j]; }
            }
        }
    }
    if (!FINAL && fr == 15) {
#pragma unroll
        for (int mt = 0; mt < LMT; ++mt) { const size_t o = ((size_t)(b * NCH + c)) * DLRU + h * 64 + (mg0 + mt) * 16 + fq * 4;
            *(f32x4*)(p.aggE + o) = st0[mt]; *(f32x4*)(p.aggP + o) = st1[mt]; }
    }
}
template <int W>
__device__ __forceinline__ void pool_block(const Params& p, int b, int gidx, int t0) {
    const int lane = threadIdx.x & 63;
    const bf16_t* src = p.proj + ((size_t)b * SEQ) * NPROJ + 2 * DLRU + gidx * 256 + lane * 4;
    bf16_t* dst = p.pooled + ((size_t)b * SEQ) * DLRU + gidx * 256 + lane * 4;
    f32x4 ring[W]; f32x4 S = (f32x4){0.f, 0.f, 0.f, 0.f};
#pragma unroll
    for (int k = 0; k < W - 1; ++k) { const int tk = t0 - W + 1 + k; f32x4 v = (f32x4){0.f, 0.f, 0.f, 0.f};
        if (tk >= 0) { const u32x2 w = *(const u32x2*)(src + (size_t)tk * NPROJ); v = (f32x4){bf_lo(w.x), bf_hi(w.x), bf_lo(w.y), bf_hi(w.y)}; }
        ring[k] = v; S += v; }
    ring[W - 1] = (f32x4){0.f, 0.f, 0.f, 0.f};
#pragma unroll 1
    for (int grp = 0; grp < 4; ++grp) {
        u32x2 rw[16];
#pragma unroll
        for (int ii = 0; ii < 16; ++ii) rw[ii] = *(const u32x2*)(src + (size_t)(t0 + grp * 16 + ii) * NPROJ);
#pragma unroll
        for (int ii = 0; ii < 16; ++ii) { const int t = t0 + grp * 16 + ii;
            const f32x4 x = (f32x4){bf_lo(rw[ii].x), bf_hi(rw[ii].x), bf_lo(rw[ii].y), bf_hi(rw[ii].y)};
            S += x;
            const float inv = (t + 1 < W) ? 1.0f / (float)(t + 1) : 1.0f / (float)W;
            const f32x4 o = S * inv - x;
            u32x2 w; w.x = cvt_pk_bf16(o[0], o[1]); w.y = cvt_pk_bf16(o[2], o[3]);
            *(u32x2*)(dst + (size_t)t * DLRU) = w;
            S -= ring[ii % W]; ring[(ii + W - 1) % W] = x; }
    }
}
__device__ __forceinline__ void pool_items(const Params& p) {
    const int wave = threadIdx.x >> 6;
    const int gw = blockIdx.x * NWAVES + wave, NGW = gridDim.x * NWAVES;
    for (int item = gw; item < NB * 4 * (SEQ / 64); item += NGW) {
        const int gidx = item & 3, blk = (item >> 2) & (SEQ / 64 - 1), b = item >> 10;
        if (gidx == 0) pool_block<2>(p, b, 0, blk * 64);
        else if (gidx == 1) pool_block<4>(p, b, 1, blk * 64);
        else if (gidx == 2) pool_block<8>(p, b, 2, blk * 64);
        else pool_block<16>(p, b, 3, blk * 64);
    }
}

constexpr int NPHASE = 10;
#ifndef PHMASK
#define PHMASK 0x3ff
#endif
#define PH_ON(k) (((PHMASK) >> (k)) & 1)
#define SYNC_BEFORE(k) if (ph_lo < (k) && (k) < ph_hi) grid.sync();
#ifndef DUPMASK
#define DUPMASK 0
#endif
#define NREP(k) ((((DUPMASK) >> (k)) & 1) ? 2 : 1)
template <int K>
__device__ __forceinline__ void run_phase(const Params& p, LAS unsigned char* lds) {
    const int G = gridDim.x, wave = threadIdx.x >> 6;
    if constexpr (K == 0) { phase0(p, (LAS float*)lds); }
    if constexpr (K == 1) { phase_norm<0>(p.x, p.g_mix, p.mod + 0 * Dm, p.mod + 1 * Dm, p.HB, nullptr); }
    if constexpr (K == 2) { pg8::Gemm g{p.HB, p.WinT, T, NPROJ, Dm, Dm, Dm, 0}; pg8::StaticOrder S; S.init(T, NPROJ, G, blockIdx.x); pg8::EpiBf16 E{p.proj, NPROJ};
        pg8::gemm_phase<pg8::EpiBf16, pg8::StaticOrder>(lds, g, S, E); }
    if constexpr (K == 3) {
        for (int item = blockIdx.x * NWAVES + wave; item < NB * 16 * (4 / LMT) * NCH; item += G * NWAVES) lru_item<false>(p, (LAS float*)lds + wave * (16 * 68), item);
        pool_items(p); }
    if constexpr (K == 4) {
        for (int item = blockIdx.x * NWAVES + wave; item < NB * 16 * (4 / LMT) * NCH; item += G * NWAVES) lru_item<true>(p, (LAS float*)lds + wave * (16 * 68), item);
        __syncthreads();
        pg8::Gemm g{p.pooled, p.WpT, T, DLRU, 256, DLRU, 256, 512}; pg8::StaticOrder S; S.init(T, DLRU, G, blockIdx.x); pg8::EpiBf16 E{p.ycat + DLRU, Dm};
        pg8::gemm_phase<pg8::EpiBf16, pg8::StaticOrder>(lds, g, S, E); }
    if constexpr (K == 5) { pg8::Gemm g{p.ycat, p.WoutT, T, Dm, Dm, Dm, Dm, 0}; pg8::StaticOrder S; S.init(T, Dm, G, blockIdx.x); pg8::EpiResid E{p.x1, p.x, p.mod + 2 * Dm};
        pg8::gemm_phase<pg8::EpiResid, pg8::StaticOrder>(lds, g, S, E); }
    if constexpr (K == 6) { phase_norm<0>(p.x1, p.g_ffn, p.mod + 3 * Dm, p.mod + 4 * Dm, p.HB, nullptr); }
    if constexpr (K == 7) { pg8::Gemm g{p.HB, p.WguT, T, NGU, Dm, Dm, Dm, 0}; pg8::StaticOrder S; S.init(T, NGU, G, blockIdx.x); pg8::EpiSwiglu E{p.act};
        pg8::gemm_phase<pg8::EpiSwiglu, pg8::StaticOrder>(lds, g, S, E); }
    if constexpr (K == 8) { pg8::Gemm g{p.act, p.WdT, T, Dm, DFF, DFF, DFF, 0}; pg8::StaticOrder S; S.init(T, Dm, G, blockIdx.x); pg8::EpiResid E{p.out, p.x1, p.mod + 5 * Dm};
        pg8::gemm_phase<pg8::EpiResid, pg8::StaticOrder>(lds, g, S, E); }
    if constexpr (K == 9) { phase_norm<1>(p.out, p.g_final, nullptr, nullptr, nullptr, p.out); }
}
#define DO_PHASE(k) SYNC_BEFORE(k) if (PH_ON(k) && ph_lo <= (k) && (k) < ph_hi) { run_phase<k>(p, lds); if (NREP(k) > 1) { grid.sync(); run_phase<k>(p, lds); } }
__global__ void __launch_bounds__(NTHREADS, 2) fwd_megakernel(Params p, int ph_lo, int ph_hi) {
    extern __shared__ __attribute__((aligned(16))) unsigned char shm[];
    LAS unsigned char* lds = (LAS unsigned char*)shm;
    cg::grid_group grid = cg::this_grid();
    DO_PHASE(0) DO_PHASE(1) DO_PHASE(2) DO_PHASE(3) DO_PHASE(4) DO_PHASE(5) DO_PHASE(6) DO_PHASE(7) DO_PHASE(8) DO_PHASE(9)
}

extern "C" void kernel_launch(void* const* d_in, const int* in_sizes, int n_in, void* d_out, int out_size, void* d_ws, size_t ws_size, hipStream_t stream) {
    constexpr size_t LDS_BYTES = pg8::STAGE_BYTES;
    static int grid_blocks = 0;
    if (!grid_blocks) {
        int dev = 0, cus = 0, per_cu = 0;
        hipGetDevice(&dev);
        hipDeviceGetAttribute(&cus, hipDeviceAttributeMultiprocessorCount, dev);
        hipFuncSetAttribute((const void*)fwd_megakernel, hipFuncAttributeMaxDynamicSharedMemorySize, (int)LDS_BYTES);
        hipOccupancyMaxActiveBlocksPerMultiprocessor(&per_cu, (const void*)fwd_megakernel, NTHREADS, LDS_BYTES);
        if (per_cu < 1) per_cu = 1;
        if (cus < 1) cus = 256;
        grid_blocks = cus * per_cu;
    }
    Params p{};
    const float* const* in = (const float* const*)d_in;
    p.x = in[0]; p.c = in[1]; p.w_ada = in[2]; p.b_ada = in[3]; p.g_mix = in[4]; p.w_in = in[5]; p.w_conv = in[6]; p.b_conv = in[7];
    p.w_rg_a = in[8]; p.b_rg_a = in[9]; p.w_rg_i = in[10]; p.b_rg_i = in[11]; p.lam = in[12]; p.w_pool = in[13]; p.ls_pool = in[14];
    p.w_out = in[15]; p.g_ffn = in[16]; p.w_gate = in[17]; p.w_up = in[18]; p.w_down = in[19]; p.g_final = in[20];
    p.out = (float*)d_out;
    unsigned char* ws = (unsigned char*)d_ws; size_t off = 0;
    auto take = [&](size_t bytes) { unsigned char* r = ws + off; off += (bytes + 255) & ~(size_t)255; return r; };
    p.WinT = (bf16_t*)take((size_t)NPROJ * Dm * 2);
    p.WoutT = (bf16_t*)take((size_t)Dm * Dm * 2);
    p.WguT = (bf16_t*)take((size_t)NGU * Dm * 2);
    p.WdT = (bf16_t*)take((size_t)Dm * DFF * 2);
    p.WpT = (bf16_t*)take((size_t)DLRU * 256 * 2);
    p.WAf = (bf16_t*)take((size_t)2 * 16 * 4096 * 2);
    p.mod = (float*)take((size_t)NB * NMOD * 4);
    p.aggP = (float*)take((size_t)NB * NCH * DLRU * 4);
    p.aggE = (float*)take((size_t)NB * NCH * DLRU * 4);
    p.HB = (bf16_t*)take((size_t)T * Dm * 2);
    p.x1 = (float*)take((size_t)T * Dm * 4);
    unsigned char* r1 = take(0);
    p.proj = (bf16_t*)take((size_t)T * NPROJ * 2);
    p.pooled = (bf16_t*)take((size_t)T * DLRU * 2);
    p.ycat = (bf16_t*)take((size_t)T * Dm * 2);
    p.act = (bf16_t*)r1;
    int ph_lo = 0, ph_hi = NPHASE;
    void* args[] = {&p, &ph_lo, &ph_hi};
    hipError_t e = hipLaunchCooperativeKernel((const void*)fwd_megakernel, dim3(grid_blocks), dim3(NTHREADS), args, (unsigned)LDS_BYTES, stream);
    if (e != hipSuccess) fprintf(stderr, "cooperative launch failed: %s (grid %d)\n", hipGetErrorString(e), grid_blocks);
}
```

```cpp
#include <hip/hip_runtime.h>
#include <hip/hip_cooperative_groups.h>
#include <cstdio>
#include <cstdint>
namespace cg = cooperative_groups;

#define LAS __attribute__((address_space(3)))
typedef unsigned short bf16_t;
typedef short bf16x8 __attribute__((ext_vector_type(8)));
typedef float f32x4 __attribute__((ext_vector_type(4)));
typedef unsigned u32x4 __attribute__((ext_vector_type(4)));
typedef unsigned u32x2 __attribute__((ext_vector_type(2)));

constexpr int Dm = 2048, NB = 2, SEQ = 16384, T = NB * SEQ, DLRU = 1024, NPROJ = 3072, DFF = 5632, NGU = 2 * DFF, NMOD = 6 * Dm;
constexpr int TC = 256, NCH = SEQ / TC;
constexpr int NTHREADS = 512, NWAVES = 8;
constexpr float EPS = 1e-6f;
constexpr float LOG2E = 1.4426950408889634f;

struct Params {
    const float *x, *c, *w_ada, *b_ada, *g_mix, *w_in, *w_conv, *b_conv, *w_rg_a, *b_rg_a, *w_rg_i, *b_rg_i, *lam, *w_pool, *ls_pool, *w_out, *g_ffn, *w_gate, *w_up, *w_down, *g_final;
    float* out;
    bf16_t *WinT, *WoutT, *WguT, *WdT, *WpT, *WAf;
    float *mod, *aggP, *aggE;
    bf16_t *HB, *proj, *pooled, *ycat, *act;
    bf16_t *d1, *d2;
};

__device__ __forceinline__ unsigned cvt_pk_bf16(float lo, float hi) { unsigned r; asm("v_cvt_pk_bf16_f32 %0, %1, %2" : "=v"(r) : "v"(lo), "v"(hi)); return r; }
__device__ __forceinline__ float bf_lo(unsigned w) { return __uint_as_float(w << 16); }
__device__ __forceinline__ float bf_hi(unsigned w) { return __uint_as_float(w & 0xffff0000u); }
__device__ __forceinline__ float fast_sigmoid(float v) { return __builtin_amdgcn_rcpf(1.0f + __builtin_amdgcn_exp2f(-LOG2E * v)); }
__device__ __forceinline__ float wave_sum(float v) {
#pragma unroll
    for (int o = 1; o < 64; o <<= 1) v += __shfl_xor(v, o);
    return v;
}

namespace pg8 {
constexpr int BM = 256, BK = 64, HALF = 128, HTB = HALF * BK * 2  , STAGE_BYTES = 8 * HTB, NXCD = 8, WGM = 8;

__host__ __device__ __forceinline__ int lds_byte(int r, int c) { const int st = (r >> 4) * 2 + (c >> 5), rr = r & 15, cc = c & 31, ob = rr * 64 + cc * 2; return st * 1024 + (ob ^ (((ob >> 9) & 1) << 5)); }
__host__ __device__ __forceinline__ void stage_rc(int b, int& R, int& C) { const int st = b / 1024, sb = b % 1024, swz = sb ^ (((sb >> 9) & 1) << 5); R = (st >> 1) * 16 + swz / 64; C = (st & 1) * 32 + (swz % 64) / 2; }
__host__ __device__ __forceinline__ int perm32(int rho) { const int n = rho >> 4, i = rho & 15; return 8 * (i >> 2) + 4 * n + (i & 3); }

struct Unit { int pm, pn; };
struct Gemm { const bf16_t* A; const bf16_t* Bt; int M, N, K, lda, ldb, a_pn_off; };

struct StaticOrder {
    int nM, nN, nwg, G, c;
    __host__ __device__ void init(int M, int N, int G_, int c_) { nM = M / BM; nN = N / BM; nwg = nM * nN; G = G_; c = c_; }
    __host__ __device__ bool next(int i, Unit& u) const {
        const long L = (long)i * G + c; if (L >= nwg) return false;
        int wgid = (int)L; { const int q = nwg / NXCD, r = nwg % NXCD, xcd = wgid % NXCD, off = wgid / NXCD; wgid = (xcd < r ? xcd * (q + 1) : r * (q + 1) + (xcd - r) * q) + off; }
        const int nig = WGM * nN, gid = wgid / nig, fm = gid * WGM, gsz = (nM - fm) < WGM ? (nM - fm) : WGM;
        u.pm = fm + ((wgid % nig) % gsz); u.pn = (wgid % nig) / gsz; return true;
    }
};

struct EpiBf16 {
    static constexpr bool PERM = true;
    bf16_t* O; int ldc;
    __device__ __forceinline__ void operator()(const f32x4 (&acc)[2][2][4][2], const Unit& u, int wr, int wc, int fr, int fq) const {
        const int row0 = u.pm * BM + wr * 64 + fr, col0 = u.pn * BM + wc * 32 + 8 * fq;
#pragma unroll
        for (int ai = 0; ai < 2; ++ai)
#pragma unroll
            for (int m = 0; m < 4; ++m) { bf16_t* rowp = O + (size_t)(row0 + ai * HALF + m * 16) * ldc + col0;
#pragma unroll
                for (int bj = 0; bj < 2; ++bj) { const f32x4 v0 = acc[ai][bj][m][0], v1 = acc[ai][bj][m][1];
                    u32x4 w; w.x = cvt_pk_bf16(v0[0], v0[1]); w.y = cvt_pk_bf16(v0[2], v0[3]); w.z = cvt_pk_bf16(v1[0], v1[1]); w.w = cvt_pk_bf16(v1[2], v1[3]);
                    *(u32x4*)(rowp + bj * HALF) = w; } }
    }
};
struct EpiGateBf16 {
    static constexpr bool PERM = true;
    bf16_t* O; const float* gate;
    __device__ __forceinline__ void operator()(const f32x4 (&acc)[2][2][4][2], const Unit& u, int wr, int wc, int fr, int fq) const {
        const int row0 = u.pm * BM + wr * 64 + fr, col0 = u.pn * BM + wc * 32 + 8 * fq;
        const float* gp = gate + (size_t)(u.pm >> 6) * NMOD + col0;
        f32x4 gv[2][2];
#pragma unroll
        for (int bj = 0; bj < 2; ++bj)
#pragma unroll
            for (int n = 0; n < 2; ++n) gv[bj][n] = *(const f32x4*)(gp + bj * HALF + n * 4);
#pragma unroll
        for (int ai = 0; ai < 2; ++ai)
#pragma unroll
            for (int m = 0; m < 4; ++m) { bf16_t* rowp = O + (size_t)(row0 + ai * HALF + m * 16) * Dm + col0;
#pragma unroll
                for (int bj = 0; bj < 2; ++bj) { const f32x4 v0 = acc[ai][bj][m][0] * gv[bj][0], v1 = acc[ai][bj][m][1] * gv[bj][1];
                    u32x4 w; w.x = cvt_pk_bf16(v0[0], v0[1]); w.y = cvt_pk_bf16(v0[2], v0[3]); w.z = cvt_pk_bf16(v1[0], v1[1]); w.w = cvt_pk_bf16(v1[2], v1[3]);
                    *(u32x4*)(rowp + bj * HALF) = w; } }
    }
};
struct EpiSwiglu {
    static constexpr bool PERM = true;
    bf16_t* O;
    __device__ __forceinline__ void operator()(const f32x4 (&acc)[2][2][4][2], const Unit& u, int wr, int wc, int fr, int fq) const {
        const int row0 = u.pm * BM + wr * 64 + fr, col0 = u.pn * HALF + wc * 32 + 8 * fq;
#pragma unroll
        for (int ai = 0; ai < 2; ++ai)
#pragma unroll
            for (int m = 0; m < 4; ++m) { bf16_t* rowp = O + (size_t)(row0 + ai * HALF + m * 16) * DFF + col0;
                f32x4 v0, v1;
#pragma unroll
                for (int j = 0; j < 4; ++j) { const float g0 = acc[ai][0][m][0][j], g1 = acc[ai][0][m][1][j];
                    v0[j] = g0 * fast_sigmoid(g0) * acc[ai][1][m][0][j]; v1[j] = g1 * fast_sigmoid(g1) * acc[ai][1][m][1][j]; }
                u32x4 w; w.x = cvt_pk_bf16(v0[0], v0[1]); w.y = cvt_pk_bf16(v0[2], v0[3]); w.z = cvt_pk_bf16(v1[0], v1[1]); w.w = cvt_pk_bf16(v1[2], v1[3]);
                *(u32x4*)rowp = w; }
    }
};

template <class Epi, class Sched, bool ALIGN_EPI = true>
__device__ __forceinline__ void gemm_phase(LAS unsigned char* lds, const Gemm g, const Sched& S, const Epi& E) {
    const int tid = threadIdx.x, wid = __builtin_amdgcn_readfirstlane(tid >> 6), lane = tid & 63, wr = wid >> 2, wc = wid & 3, fr = lane & 15, fq = lane >> 4;
    const int K = g.K, nt = K / BK;
    unsigned voffA[2], voffB[2];
#pragma unroll
    for (int i = 0; i < 2; ++i) { int R, C; stage_rc(tid * 16 + i * 8192, R, C); const int Rb = Epi::PERM ? ((R & ~31) + perm32(R & 31)) : R;
        voffA[i] = (unsigned)(R * g.lda + C) * 2u; voffB[i] = (unsigned)(Rb * g.ldb + C) * 2u; }
    const size_t kstep = (size_t)(BK * 2);
    const size_t hstepA = (size_t)HALF * g.lda * 2, hstepB = (size_t)HALF * g.ldb * 2;
    const size_t tstepA = 2 * hstepA, tstepB = 2 * hstepB;
    const unsigned ldsw = (unsigned)wid * 1024u;
    const int aoff = lds_byte(wr * 64 + fr, fq * 8), boff = lds_byte(wc * 32 + fr, fq * 8);
#define PG8_SA(b, h) (((b) * 2 + (h)) * HTB)
#define PG8_SB(b, h) ((4 + (b) * 2 + (h)) * HTB)
#define PG8_STAGE(bufoff, gbase, voff) do { _Pragma("unroll") for (int _i = 0; _i < 2; ++_i) \
        __builtin_amdgcn_global_load_lds((const unsigned*)((const char*)(gbase) + (voff)[_i]), (LAS unsigned*)(lds + (bufoff) + ldsw + _i * 8192), 16, 0, 0); } while (0)
#define PG8_LDA(dst, b, h) do { _Pragma("unroll") for (int m = 0; m < 4; ++m) _Pragma("unroll") for (int k = 0; k < 2; ++k) dst[m][k] = *(const LAS bf16x8*)(lds + PG8_SA(b, h) + aoff + m * 2048 + k * 1024); } while (0)
#define PG8_LDB(dst, b, h) do { _Pragma("unroll") for (int n = 0; n < 2; ++n) _Pragma("unroll") for (int k = 0; k < 2; ++k) dst[n][k] = *(const LAS bf16x8*)(lds + PG8_SB(b, h) + boff + n * 2048 + k * 1024); } while (0)
#define PG8_MMA(ai, bj, At, Bt) do { __builtin_amdgcn_s_setprio(1); _Pragma("unroll") for (int m = 0; m < 4; ++m) _Pragma("unroll") for (int n = 0; n < 2; ++n) _Pragma("unroll") for (int k = 0; k < 2; ++k) \
        acc[ai][bj][m][n] = __builtin_amdgcn_mfma_f32_16x16x32_bf16(Bt[n][k], At[m][k], acc[ai][bj][m][n], 0, 0, 0); __builtin_amdgcn_s_setprio(0); } while (0)
#define PG8_WAIT_V(n) asm volatile("s_waitcnt vmcnt(" #n ")" ::: "memory")
#define PG8_WAIT_L(n) asm volatile("s_waitcnt lgkmcnt(" #n ")" ::: "memory")
#define PG8_BAR __builtin_amdgcn_s_barrier()
#define PG8_SCHED __builtin_amdgcn_sched_barrier(0)
    Unit cur, nxt; int ui = 0;
    if (!S.next(0, cur)) return;
    f32x4 acc[2][2][4][2];
#pragma unroll
    for (int a = 0; a < 2; ++a)
#pragma unroll
        for (int b = 0; b < 2; ++b)
#pragma unroll
            for (int m = 0; m < 4; ++m)
#pragma unroll
                for (int n = 0; n < 2; ++n) acc[a][b][m][n] = (f32x4){0.f, 0.f, 0.f, 0.f};
    bf16x8 At[4][2], B0[2][2], B1[2][2];
    const char* cA = (const char*)g.A + (size_t)cur.pm * tstepA + (size_t)cur.pn * g.a_pn_off; const char* cB = (const char*)g.Bt + (size_t)cur.pn * tstepB;
    PG8_STAGE(PG8_SB(0, 0), cB, voffB); PG8_STAGE(PG8_SB(0, 1), cB + hstepB, voffB); PG8_STAGE(PG8_SA(0, 0), cA, voffA); PG8_STAGE(PG8_SA(0, 1), cA + hstepA, voffA);
    if (wr == 1) PG8_BAR;
    PG8_WAIT_V(2); PG8_BAR;
    PG8_STAGE(PG8_SB(1, 0), cB + kstep, voffB); PG8_STAGE(PG8_SA(1, 0), cA + kstep, voffA); PG8_STAGE(PG8_SB(1, 1), cB + hstepB + kstep, voffB);
    PG8_WAIT_V(6); PG8_BAR;
    for (;;) {
        const bool has_next = S.next(ui + 1, nxt);
        const char* nA = has_next ? (const char*)g.A + (size_t)nxt.pm * tstepA + (size_t)nxt.pn * g.a_pn_off : cA; const char* nB = has_next ? (const char*)g.Bt + (size_t)nxt.pn * tstepB : cB;
        for (int t = 0; t < nt; t += 2) {
            const bool last = (t == nt - 2);
            const char* a1 = cA + (size_t)(t + 1) * kstep;
            const char* a2 = last ? nA : cA + (size_t)(t + 2) * kstep; const char* b2 = last ? nB : cB + (size_t)(t + 2) * kstep;
            const char* a3 = a2 + kstep; const char* b3 = b2 + kstep;
            PG8_LDB(B0, 0, 0); PG8_LDB(B1, 0, 1); PG8_SCHED; PG8_LDA(At, 0, 0); PG8_STAGE(PG8_SA(1, 1), a1 + hstepA, voffA);
            PG8_WAIT_V(8); PG8_WAIT_L(0); PG8_BAR; PG8_MMA(0, 0, At, B0); PG8_MMA(0, 1, At, B1); PG8_BAR; PG8_SCHED;
            PG8_LDA(At, 0, 1); PG8_STAGE(PG8_SB(0, 0), b2, voffB); PG8_STAGE(PG8_SB(0, 1), b2 + hstepB, voffB); PG8_STAGE(PG8_SA(0, 0), a2, voffA);
            PG8_WAIT_V(8); PG8_WAIT_L(0); PG8_BAR; PG8_MMA(1, 0, At, B0); PG8_MMA(1, 1, At, B1); PG8_BAR; PG8_SCHED;
            PG8_LDB(B0, 1, 0); PG8_LDB(B1, 1, 1); PG8_SCHED; PG8_LDA(At, 1, 0); PG8_STAGE(PG8_SA(0, 1), a2 + hstepA, voffA);
            PG8_WAIT_V(8); PG8_WAIT_L(0); PG8_BAR; PG8_MMA(0, 0, At, B0); PG8_MMA(0, 1, At, B1); PG8_BAR; PG8_SCHED;
            PG8_LDA(At, 1, 1); PG8_STAGE(PG8_SB(1, 0), b3, voffB); PG8_STAGE(PG8_SB(1, 1), b3 + hstepB, voffB); PG8_STAGE(PG8_SA(1, 0), a3, voffA);
            PG8_WAIT_V(8); PG8_WAIT_L(0); PG8_BAR; PG8_MMA(1, 0, At, B0); PG8_MMA(1, 1, At, B1); PG8_BAR; PG8_SCHED;
        }
        if constexpr (ALIGN_EPI) { if (wr == 0) PG8_BAR; }
        E(acc, cur, wr, wc, fr, fq);
        if (!has_next) break;
#pragma unroll
        for (int a = 0; a < 2; ++a)
#pragma unroll
            for (int b = 0; b < 2; ++b)
#pragma unroll
                for (int m = 0; m < 4; ++m)
#pragma unroll
                    for (int n = 0; n < 2; ++n) acc[a][b][m][n] = (f32x4){0.f, 0.f, 0.f, 0.f};
        cur = nxt; cA = nA; cB = nB; ++ui;
        if constexpr (ALIGN_EPI) { if (wr == 1) PG8_BAR; }
    }
    PG8_WAIT_V(0);
    if constexpr (!ALIGN_EPI) { if (wr == 0) PG8_BAR; }
    PG8_BAR;
#undef PG8_SA
#undef PG8_SB
#undef PG8_STAGE
#undef PG8_LDA
#undef PG8_LDB
#undef PG8_MMA
#undef PG8_WAIT_V
#undef PG8_WAIT_L
#undef PG8_BAR
#undef PG8_SCHED
}
}

__device__ __forceinline__ void mod_task(const Params& p, LAS float* lds, int jg) {
    const int tid = threadIdx.x;
    LAS float* sc = lds;
    LAS float* red = lds + 4096;
    for (int i = tid; i < NB * Dm; i += NTHREADS) { const float v = p.c[i]; sc[i] = v * fast_sigmoid(v); }
    __syncthreads();
    const int c4 = tid & 31, ks = tid >> 5;
    const float* wp = p.w_ada + (size_t)(ks * 128) * NMOD + jg * 128 + c4 * 4;
    f32x4 a0 = (f32x4){0.f, 0.f, 0.f, 0.f}, a1 = a0;
#pragma unroll 8
    for (int kk = 0; kk < 128; ++kk) {
        const f32x4 w = *(const f32x4*)(wp + (size_t)kk * NMOD);
        const float s0 = sc[ks * 128 + kk], s1 = sc[Dm + ks * 128 + kk];
        a0 += s0 * w; a1 += s1 * w;
    }
    *(LAS f32x4*)(red + (ks * 2 + 0) * 128 + c4 * 4) = a0;
    *(LAS f32x4*)(red + (ks * 2 + 1) * 128 + c4 * 4) = a1;
    __syncthreads();
    if (tid < 256) { const int b = tid >> 7, j = tid & 127; float s = p.b_ada[jg * 128 + j];
#pragma unroll
        for (int k2 = 0; k2 < 16; ++k2) s += red[(k2 * 2 + b) * 128 + j];
        p.mod[(size_t)b * NMOD + jg * 128 + j] = s; }
    __syncthreads();
}
__device__ __forceinline__ void transpose_tile(const float* src, int N, bf16_t* dst, int ldd, int mode, const float* scale, int tile, LAS float* lds) {
    const int tid = threadIdx.x, ntn = N >> 6, kt = tile / ntn, ntile = tile - kt * ntn, k0 = kt * 64, n0 = ntile * 64;
    { const int kr = tid >> 4, n4 = (tid & 15) * 4;
#pragma unroll
      for (int i = 0; i < 2; ++i) { const f32x4 v = *(const f32x4*)(src + (size_t)(k0 + kr + 32 * i) * N + n0 + n4);
          LAS float* d = lds + (kr + 32 * i) * 65 + n4; d[0] = v[0]; d[1] = v[1]; d[2] = v[2]; d[3] = v[3]; } }
    __syncthreads();
    { const int n = tid >> 3, k8 = tid & 7; const LAS float* s = lds + (k8 * 8) * 65 + n; const int nn = n0 + n;
      const float sc = scale ? scale[nn] : 1.0f;
      u32x4 o; o.x = cvt_pk_bf16(s[0] * sc, s[65] * sc); o.y = cvt_pk_bf16(s[2 * 65] * sc, s[3 * 65] * sc); o.z = cvt_pk_bf16(s[4 * 65] * sc, s[5 * 65] * sc); o.w = cvt_pk_bf16(s[6 * 65] * sc, s[7 * 65] * sc);
      const int drow = mode == 0 ? nn : (256 * (nn >> 7) + (nn & 127) + (mode == 2 ? 128 : 0));
      *(u32x4*)(dst + (size_t)drow * ldd + k0 + k8 * 8) = o; }
    __syncthreads();
}
__device__ __forceinline__ void phase0(const Params& p, LAS float* lds) {
    const int G = gridDim.x;
    constexpr int T_MOD = NMOD / 128;
    constexpr int T_IN = (Dm / 64) * (NPROJ / 64), T_OUT = (Dm / 64) * (Dm / 64), T_G = (Dm / 64) * (DFF / 64), T_D = (DFF / 64) * (Dm / 64), T_P = 4 * 16;
    constexpr int NTASK = T_MOD + T_IN + T_OUT + 2 * T_G + T_D + T_P;
    for (int task = blockIdx.x; task < NTASK; task += G) {
        int r = task;
        if (r < T_MOD) { mod_task(p, lds, r); continue; } r -= T_MOD;
        if (r < T_IN) { transpose_tile(p.w_in, NPROJ, p.WinT, Dm, 0, nullptr, r, lds); continue; } r -= T_IN;
        if (r < T_OUT) { transpose_tile(p.w_out, Dm, p.WoutT, Dm, 0, nullptr, r, lds); continue; } r -= T_OUT;
        if (r < T_G) { transpose_tile(p.w_gate, DFF, p.WguT, Dm, 1, nullptr, r, lds); continue; } r -= T_G;
        if (r < T_G) { transpose_tile(p.w_up, DFF, p.WguT, Dm, 2, nullptr, r, lds); continue; } r -= T_G;
        if (r < T_D) { transpose_tile(p.w_down, Dm, p.WdT, DFF, 0, nullptr, r, lds); continue; } r -= T_D;
        { const int gidx = r >> 4; transpose_tile(p.w_pool + (size_t)gidx * 65536, 256, p.WpT + (size_t)gidx * 65536, 256, 0, p.ls_pool + gidx * 256, r & 15, lds); }
    }
    for (int e = blockIdx.x * NTHREADS + threadIdx.x; e < 2 * 16 * 4096; e += G * NTHREADS) {
        const int el = e & 7, ln = (e >> 3) & 63, ks = (e >> 9) & 1, mt = (e >> 10) & 3, h = (e >> 12) & 15, gate = e >> 16;
        const int in = ks * 32 + (ln >> 4) * 8 + el, out = mt * 16 + (ln & 15);
        const float* w = gate ? p.w_rg_i : p.w_rg_a;
        p.WAf[e] = (bf16_t)(cvt_pk_bf16(w[(size_t)(h * 64 + in) * 64 + out], 0.f) & 0xffffu);
    }
}

template <int ND, bool FINAL>
__device__ __forceinline__ void phase_norm(const float* xin, const bf16_t* d1, const bf16_t* d2, const float* g, const float* sh, const float* sc, bf16_t* hb, float* outf) {
    const int lane = threadIdx.x & 63, wave = threadIdx.x >> 6;
    const int gw = blockIdx.x * NWAVES + wave, NGW = gridDim.x * NWAVES, rpw = (T + NGW - 1) / NGW;
    f32x4 fv[4][2], sv[4][2];
    int curb = -1;
    for (int i = 0; i < rpw; ++i) {
        const int row = gw * rpw + i; if (row >= T) break;
        const int b = row >> 14;
        if (b != curb) { curb = b;
#pragma unroll
            for (int j = 0; j < 4; ++j)
#pragma unroll
                for (int q = 0; q < 2; ++q) { const int k = (j * 64 + lane) * 8 + q * 4; const f32x4 gg = *(const f32x4*)(g + k);
                    if (!FINAL) { const f32x4 s = *(const f32x4*)(sc + (size_t)b * NMOD + k); fv[j][q] = gg * (1.0f + s); sv[j][q] = *(const f32x4*)(sh + (size_t)b * NMOD + k); }
                    else { fv[j][q] = gg; sv[j][q] = (f32x4){0.f, 0.f, 0.f, 0.f}; } } }
        const float* xr = xin + (size_t)row * Dm;
        f32x4 v[4][2]; float ss = 0.f;
#pragma unroll
        for (int j = 0; j < 4; ++j) {
            const int k = (j * 64 + lane) * 8;
            v[j][0] = *(const f32x4*)(xr + k); v[j][1] = *(const f32x4*)(xr + k + 4);
            if (ND >= 1) { const u32x4 w = *(const u32x4*)(d1 + (size_t)row * Dm + k);
                v[j][0] += (f32x4){bf_lo(w.x), bf_hi(w.x), bf_lo(w.y), bf_hi(w.y)}; v[j][1] += (f32x4){bf_lo(w.z), bf_hi(w.z), bf_lo(w.w), bf_hi(w.w)}; }
            if (ND >= 2) { const u32x4 w = *(const u32x4*)(d2 + (size_t)row * Dm + k);
                v[j][0] += (f32x4){bf_lo(w.x), bf_hi(w.x), bf_lo(w.y), bf_hi(w.y)}; v[j][1] += (f32x4){bf_lo(w.z), bf_hi(w.z), bf_lo(w.w), bf_hi(w.w)}; }
#pragma unroll
            for (int q = 0; q < 2; ++q) { const f32x4 t = v[j][q] * v[j][q]; ss += (t[0] + t[1]) + (t[2] + t[3]); }
        }
        ss = wave_sum(ss);
        const float rstd = 1.0f / sqrtf(ss * (1.0f / Dm) + EPS);
#pragma unroll
        for (int j = 0; j < 4; ++j) {
            const f32x4 o0 = v[j][0] * rstd * fv[j][0] + sv[j][0], o1 = v[j][1] * rstd * fv[j][1] + sv[j][1];
            if (!FINAL) { u32x4 w; w.x = cvt_pk_bf16(o0[0], o0[1]); w.y = cvt_pk_bf16(o0[2], o0[3]); w.z = cvt_pk_bf16(o1[0], o1[1]); w.w = cvt_pk_bf16(o1[2], o1[3]);
                *(u32x4*)(hb + (size_t)row * Dm + (j * 64 + lane) * 8) = w; }
            else { float* op = outf + (size_t)row * Dm + (j * 64 + lane) * 8; *(f32x4*)op = o0; *(f32x4*)(op + 4) = o1; }
        }
    }
}

template <int CTRL> __device__ __forceinline__ float dppf(float oldv, float v) {
    return __builtin_bit_cast(float, __builtin_amdgcn_update_dpp(__builtin_bit_cast(int, oldv), __builtin_bit_cast(int, v), CTRL, 0xf, 0xf, false));
}
constexpr int LMT = 2;
template <bool FINAL>
__device__ __forceinline__ void lru_item(const Params& p, LAS float* tile  , int item) {
    const int lane = threadIdx.x & 63, fr = lane & 15, fq = lane >> 4;
    const int c = item & (NCH - 1), mg0 = ((item >> 6) & 1) * LMT, h = (item >> 7) & 15, b = item >> 11;
    const size_t rowbase = (size_t)b * SEQ;
    const int cch = h * 64 + 4 * fr;
    const f32x4 cw0 = *(const f32x4*)(p.w_conv + 0 * DLRU + cch), cw1 = *(const f32x4*)(p.w_conv + 1 * DLRU + cch), cw2 = *(const f32x4*)(p.w_conv + 2 * DLRU + cch), cw3 = *(const f32x4*)(p.w_conv + 3 * DLRU + cch);
    const f32x4 cbv = *(const f32x4*)(p.b_conv + cch);
    f32x4 ba[LMT], bi[LMT], cl[LMT];
    bf16x8 wa[LMT][2], wi[LMT][2];
#pragma unroll
    for (int mt = 0; mt < LMT; ++mt) { const int ch = h * 64 + (mg0 + mt) * 16 + fq * 4;
        ba[mt] = *(const f32x4*)(p.b_rg_a + ch); bi[mt] = *(const f32x4*)(p.b_rg_i + ch);
        const f32x4 lm = *(const f32x4*)(p.lam + ch);
#pragma unroll
        for (int j = 0; j < 4; ++j) { const float xl = lm[j]; cl[mt][j] = (8.0f * LOG2E) * (fminf(xl, 0.f) - log1pf(expf(-fabsf(xl)))); }
#pragma unroll
        for (int ks = 0; ks < 2; ++ks) {
            wa[mt][ks] = *(const bf16x8*)(p.WAf + ((size_t)(((0 * 16 + h) * 4 + mg0 + mt) * 2 + ks) * 64 + lane) * 8);
            wi[mt][ks] = *(const bf16x8*)(p.WAf + ((size_t)(((1 * 16 + h) * 4 + mg0 + mt) * 2 + ks) * 64 + lane) * 8); } }
    f32x4 st0[LMT], st1[LMT];
#pragma unroll
    for (int mt = 0; mt < LMT; ++mt) { st0[mt] = (f32x4){0.f, 0.f, 0.f, 0.f}; st1[mt] = (f32x4){1.f, 1.f, 1.f, 1.f}; }
    u32x2 raw[7]; u32x2 graw[LMT];
    const bf16_t* xsrc = p.proj + (rowbase + (size_t)c * TC) * NPROJ + cch;
    const bf16_t* gsrc = p.proj + (rowbase + (size_t)c * TC + fr) * NPROJ + DLRU + h * 64 + mg0 * 16 + fq * 4;
#pragma unroll
    for (int i = 0; i < 7; ++i) { const int dt = 4 * fq - 3 + i;
        if (c * TC + dt >= 0) raw[i] = *(const u32x2*)(xsrc + (long)dt * NPROJ); else raw[i] = (u32x2){0u, 0u}; }
    if (FINAL) {
#pragma unroll
        for (int mt = 0; mt < LMT; ++mt) graw[mt] = *(const u32x2*)(gsrc + mt * 16);
        float hin = 0.f; const int ch = h * 64 + lane;
        const float* pP = p.aggP + (size_t)(b * NCH) * DLRU + ch; const float* pE = p.aggE + (size_t)(b * NCH) * DLRU + ch;
#pragma unroll 8
        for (int cc = 0; cc < c; ++cc) hin = pP[(size_t)cc * DLRU] * hin + pE[(size_t)cc * DLRU];
#pragma unroll
        for (int mt = 0; mt < LMT; ++mt)
#pragma unroll
            for (int j = 0; j < 4; ++j) st0[mt][j] = __shfl(hin, (mg0 + mt) * 16 + fq * 4 + j);
    }
#pragma unroll 1
    for (int nt = 0; nt < TC / 16; ++nt) {
        f32x4 xv[7];
#pragma unroll
        for (int i = 0; i < 7; ++i) xv[i] = (f32x4){bf_lo(raw[i].x), bf_hi(raw[i].x), bf_lo(raw[i].y), bf_hi(raw[i].y)};
        f32x4 gg[LMT];
        if (FINAL) {
#pragma unroll
            for (int mt = 0; mt < LMT; ++mt) gg[mt] = (f32x4){bf_lo(graw[mt].x), bf_hi(graw[mt].x), bf_lo(graw[mt].y), bf_hi(graw[mt].y)};
        }
        if (nt + 1 < TC / 16) {
            const bf16_t* xn = xsrc + (size_t)(nt + 1) * 16 * NPROJ;
#pragma unroll
            for (int i = 0; i < 7; ++i) raw[i] = *(const u32x2*)(xn + (long)(4 * fq - 3 + i) * NPROJ);
            if (FINAL) {
#pragma unroll
                for (int mt = 0; mt < LMT; ++mt) graw[mt] = *(const u32x2*)(gsrc + (size_t)(nt + 1) * 16 * NPROJ + mt * 16);
            }
        }
        asm volatile("" ::: "memory"); __builtin_amdgcn_wave_barrier();
#pragma unroll
        for (int j = 0; j < 4; ++j) { const f32x4 xc = cbv + cw0 * xv[j] + cw1 * xv[j + 1] + cw2 * xv[j + 2] + cw3 * xv[j + 3];
            *(LAS f32x4*)(tile + (4 * fq + j) * 68 + 4 * fr) = xc; }
        asm volatile("" ::: "memory"); __builtin_amdgcn_wave_barrier();
        bf16x8 bfr[2]; f32x4 xd[LMT];
#pragma unroll
        for (int ks = 0; ks < 2; ++ks) { const f32x4 lo = *(const LAS f32x4*)(tile + fr * 68 + ks * 32 + fq * 8), hi = *(const LAS f32x4*)(tile + fr * 68 + ks * 32 + fq * 8 + 4);
            u32x4 w; w.x = cvt_pk_bf16(lo[0], lo[1]); w.y = cvt_pk_bf16(lo[2], lo[3]); w.z = cvt_pk_bf16(hi[0], hi[1]); w.w = cvt_pk_bf16(hi[2], hi[3]);
            bfr[ks] = __builtin_bit_cast(bf16x8, w); }
#pragma unroll
        for (int mt = 0; mt < LMT; ++mt) xd[mt] = *(const LAS f32x4*)(tile + fr * 68 + (mg0 + mt) * 16 + fq * 4);
        asm volatile("" ::: "memory"); __builtin_amdgcn_wave_barrier();
        const size_t trow = rowbase + (size_t)c * TC + nt * 16 + fr;
#pragma unroll
        for (int mt = 0; mt < LMT; ++mt) {
            f32x4 dr = (f32x4){0.f, 0.f, 0.f, 0.f}, di = dr;
            dr = __builtin_amdgcn_mfma_f32_16x16x32_bf16(wa[mt][0], bfr[0], dr, 0, 0, 0); dr = __builtin_amdgcn_mfma_f32_16x16x32_bf16(wa[mt][1], bfr[1], dr, 0, 0, 0);
            di = __builtin_amdgcn_mfma_f32_16x16x32_bf16(wi[mt][0], bfr[0], di, 0, 0, 0); di = __builtin_amdgcn_mfma_f32_16x16x32_bf16(wi[mt][1], bfr[1], di, 0, 0, 0);
            f32x4 av, uv;
#pragma unroll
            for (int j = 0; j < 4; ++j) {
                const float r = fast_sigmoid(dr[j] + ba[mt][j]), ig = fast_sigmoid(di[j] + bi[mt][j]);
                float a = __builtin_amdgcn_exp2f(r * cl[mt][j]);
                float u = __builtin_amdgcn_sqrtf(1.0f - a * a) * ig * xd[mt][j];
                float ap, up;
                ap = dppf<0x111>(1.f, a); up = dppf<0x111>(0.f, u); u = fmaf(a, up, u); a *= ap;
                ap = dppf<0x112>(1.f, a); up = dppf<0x112>(0.f, u); u = fmaf(a, up, u); a *= ap;
                ap = dppf<0x114>(1.f, a); up = dppf<0x114>(0.f, u); u = fmaf(a, up, u); a *= ap;
                ap = dppf<0x118>(1.f, a); up = dppf<0x118>(0.f, u); u = fmaf(a, up, u); a *= ap;
                av[j] = a; uv[j] = u;
            }
            if (FINAL) {
                const int ch = h * 64 + (mg0 + mt) * 16 + fq * 4;
                f32x4 y;
#pragma unroll
                for (int j = 0; j < 4; ++j) { const float hh = fmaf(av[j], st0[mt][j], uv[j]);
                    st0[mt][j] = __shfl(hh, lane | 15);
                    const float gx = gg[mt][j]; const float ge = gx * fast_sigmoid(1.5957691216057308f * (gx + 0.044715f * gx * gx * gx));
                    y[j] = hh * ge; }
                u32x2 w; w.x = cvt_pk_bf16(y[0], y[1]); w.y = cvt_pk_bf16(y[2], y[3]);
                *(u32x2*)(p.ycat + trow * Dm + ch) = w;
            } else {
#pragma unroll
                for (int j = 0; j < 4; ++j) { st0[mt][j] = fmaf(av[j], st0[mt][j], uv[j]); st1[mt][j] *= av[j]; }
            }
        }
    }
    if (!FINAL && fr == 15) {
#pragma unroll
        for (int mt = 0; mt < LMT; ++mt) { const size_t o = ((size_t)(b * NCH + c)) * DLRU + h * 64 + (mg0 + mt) * 16 + fq * 4;
            *(f32x4*)(p.aggE + o) = st0[mt]; *(f32x4*)(p.aggP + o) = st1[mt]; }
    }
}
template <int W>
__device__ __forceinline__ void pool_block(const Params& p, int b, int gidx, int t0) {
    const int lane = threadIdx.x & 63;
    const bf16_t* src = p.proj + ((size_t)b * SEQ) * NPROJ + 2 * DLRU + gidx * 256 + lane * 4;
    bf16_t* dst = p.pooled + ((size_t)b * SEQ) * DLRU + gidx * 256 + lane * 4;
    f32x4 ring[W]; f32x4 S = (f32x4){0.f, 0.f, 0.f, 0.f};
#pragma unroll
    for (int k = 0; k < W - 1; ++k) { const int tk = t0 - W + 1 + k; f32x4 v = (f32x4){0.f, 0.f, 0.f, 0.f};
        if (tk >= 0) { const u32x2 w = *(const u32x2*)(src + (size_t)tk * NPROJ); v = (f32x4){bf_lo(w.x), bf_hi(w.x), bf_lo(w.y), bf_hi(w.y)}; }
        ring[k] = v; S += v; }
    ring[W - 1] = (f32x4){0.f, 0.f, 0.f, 0.f};
#pragma unroll 1
    for (int grp = 0; grp < 4; ++grp) {
        u32x2 rw[16];
#pragma unroll
        for (int ii = 0; ii < 16; ++ii) rw[ii] = *(const u32x2*)(src + (size_t)(t0 + grp * 16 + ii) * NPROJ);
#pragma unroll
        for (int ii = 0; ii < 16; ++ii) { const int t = t0 + grp * 16 + ii;
            const f32x4 x = (f32x4){bf_lo(rw[ii].x), bf_hi(rw[ii].x), bf_lo(rw[ii].y), bf_hi(rw[ii].y)};
            S += x;
            const float inv = (t + 1 < W) ? 1.0f / (float)(t + 1) : 1.0f / (float)W;
            const f32x4 o = S * inv - x;
            u32x2 w; w.x = cvt_pk_bf16(o[0], o[1]); w.y = cvt_pk_bf16(o[2], o[3]);
            *(u32x2*)(dst + (size_t)t * DLRU) = w;
            S -= ring[ii % W]; ring[(ii + W - 1) % W] = x; }
    }
}
__device__ __forceinline__ void pool_items(const Params& p) {
    const int wave = threadIdx.x >> 6;
    const int gw = blockIdx.x * NWAVES + wave, NGW = gridDim.x * NWAVES;
    for (int item = gw; item < NB * 4 * (SEQ / 64); item += NGW) {
        const int gidx = item & 3, blk = (item >> 2) & (SEQ / 64 - 1), b = item >> 10;
        if (gidx == 0) pool_block<2>(p, b, 0, blk * 64);
        else if (gidx == 1) pool_block<4>(p, b, 1, blk * 64);
        else if (gidx == 2) pool_block<8>(p, b, 2, blk * 64);
        else pool_block<16>(p, b, 3, blk * 64);
    }
}

constexpr int NPHASE = 10;
#ifndef PHMASK
#define PHMASK 0x3ff
#endif
#define PH_ON(k) (((PHMASK) >> (k)) & 1)
#define SYNC_BEFORE(k) if (ph_lo < (k) && (k) < ph_hi) grid.sync();
#ifndef DUPMASK
#define DUPMASK 0
#endif
#define NREP(k) ((((DUPMASK) >> (k)) & 1) ? 2 : 1)
template <int K>
__device__ __forceinline__ void run_phase(const Params& p, LAS unsigned char* lds) {
    const int G = gridDim.x, wave = threadIdx.x >> 6;
    if constexpr (K == 0) { phase0(p, (LAS float*)lds); }
    if constexpr (K == 1) { phase_norm<0, false>(p.x, nullptr, nullptr, p.g_mix, p.mod + 0 * Dm, p.mod + 1 * Dm, p.HB, nullptr); }
    if constexpr (K == 2) { pg8::Gemm g{p.HB, p.WinT, T, NPROJ, Dm, Dm, Dm, 0}; pg8::StaticOrder S; S.init(T, NPROJ, G, blockIdx.x); pg8::EpiBf16 E{p.proj, NPROJ};
        pg8::gemm_phase<pg8::EpiBf16, pg8::StaticOrder>(lds, g, S, E); }
    if constexpr (K == 3) {
        for (int item = blockIdx.x * NWAVES + wave; item < NB * 16 * (4 / LMT) * NCH; item += G * NWAVES) lru_item<false>(p, (LAS float*)lds + wave * (16 * 68), item);
        pool_items(p); }
    if constexpr (K == 4) {
        for (int item = blockIdx.x * NWAVES + wave; item < NB * 16 * (4 / LMT) * NCH; item += G * NWAVES) lru_item<true>(p, (LAS float*)lds + wave * (16 * 68), item);
        __syncthreads();
        pg8::Gemm g{p.pooled, p.WpT, T, DLRU, 256, DLRU, 256, 512}; pg8::StaticOrder S; S.init(T, DLRU, G, blockIdx.x); pg8::EpiBf16 E{p.ycat + DLRU, Dm};
        pg8::gemm_phase<pg8::EpiBf16, pg8::StaticOrder>(lds, g, S, E); }
    if constexpr (K == 5) { pg8::Gemm g{p.ycat, p.WoutT, T, Dm, Dm, Dm, Dm, 0}; pg8::StaticOrder S; S.init(T, Dm, G, blockIdx.x); pg8::EpiGateBf16 E{p.d1, p.mod + 2 * Dm};
        pg8::gemm_phase<pg8::EpiGateBf16, pg8::StaticOrder>(lds, g, S, E); }
    if constexpr (K == 6) { phase_norm<1, false>(p.x, p.d1, nullptr, p.g_ffn, p.mod + 3 * Dm, p.mod + 4 * Dm, p.HB, nullptr); }
    if constexpr (K == 7) { pg8::Gemm g{p.HB, p.WguT, T, NGU, Dm, Dm, Dm, 0}; pg8::StaticOrder S; S.init(T, NGU, G, blockIdx.x); pg8::EpiSwiglu E{p.act};
        pg8::gemm_phase<pg8::EpiSwiglu, pg8::StaticOrder>(lds, g, S, E); }
    if constexpr (K == 8) { pg8::Gemm g{p.act, p.WdT, T, Dm, DFF, DFF, DFF, 0}; pg8::StaticOrder S; S.init(T, Dm, G, blockIdx.x); pg8::EpiGateBf16 E{p.d2, p.mod + 5 * Dm};
        pg8::gemm_phase<pg8::EpiGateBf16, pg8::StaticOrder>(lds, g, S, E); }
    if constexpr (K == 9) { phase_norm<2, true>(p.x, p.d1, p.d2, p.g_final, nullptr, nullptr, nullptr, p.out); }
}
#define DO_PHASE(k) SYNC_BEFORE(k) if (PH_ON(k) && ph_lo <= (k) && (k) < ph_hi) { run_phase<k>(p, lds); if (NREP(k) > 1) { grid.sync(); run_phase<k>(p, lds); } }
__global__ void __launch_bounds__(NTHREADS, 2) fwd_megakernel(Params p, int ph_lo, int ph_hi) {
    extern __shared__ __attribute__((aligned(16))) unsigned char shm[];
    LAS unsigned char* lds = (LAS unsigned char*)shm;
    cg::grid_group grid = cg::this_grid();
    DO_PHASE(0) DO_PHASE(1) DO_PHASE(2) DO_PHASE(3) DO_PHASE(4) DO_PHASE(5) DO_PHASE(6) DO_PHASE(7) DO_PHASE(8) DO_PHASE(9)
}

extern "C" void kernel_launch(void* const* d_in, const int* in_sizes, int n_in, void* d_out, int out_size, void* d_ws, size_t ws_size, hipStream_t stream) {
    constexpr size_t LDS_BYTES = pg8::STAGE_BYTES;
    static int grid_blocks = 0;
    if (!grid_blocks) {
        int dev = 0, cus = 0, per_cu = 0;
        hipGetDevice(&dev);
        hipDeviceGetAttribute(&cus, hipDeviceAttributeMultiprocessorCount, dev);
        hipFuncSetAttribute((const void*)fwd_megakernel, hipFuncAttributeMaxDynamicSharedMemorySize, (int)LDS_BYTES);
        hipOccupancyMaxActiveBlocksPerMultiprocessor(&per_cu, (const void*)fwd_megakernel, NTHREADS, LDS_BYTES);
        if (per_cu < 1) per_cu = 1;
        if (cus < 1) cus = 256;
        grid_blocks = cus * per_cu;
    }
    Params p{};
    const float* const* in = (const float* const*)d_in;
    p.x = in[0]; p.c = in[1]; p.w_ada = in[2]; p.b_ada = in[3]; p.g_mix = in[4]; p.w_in = in[5]; p.w_conv = in[6]; p.b_conv = in[7];
    p.w_rg_a = in[8]; p.b_rg_a = in[9]; p.w_rg_i = in[10]; p.b_rg_i = in[11]; p.lam = in[12]; p.w_pool = in[13]; p.ls_pool = in[14];
    p.w_out = in[15]; p.g_ffn = in[16]; p.w_gate = in[17]; p.w_up = in[18]; p.w_down = in[19]; p.g_final = in[20];
    p.out = (float*)d_out;
    unsigned char* ws = (unsigned char*)d_ws; size_t off = 0;
    auto take = [&](size_t bytes) { unsigned char* r = ws + off; off += (bytes + 255) & ~(size_t)255; return r; };
    p.WinT = (bf16_t*)take((size_t)NPROJ * Dm * 2);
    p.WoutT = (bf16_t*)take((size_t)Dm * Dm * 2);
    p.WguT = (bf16_t*)take((size_t)NGU * Dm * 2);
    p.WdT = (bf16_t*)take((size_t)Dm * DFF * 2);
    p.WpT = (bf16_t*)take((size_t)DLRU * 256 * 2);
    p.WAf = (bf16_t*)take((size_t)2 * 16 * 4096 * 2);
    p.mod = (float*)take((size_t)NB * NMOD * 4);
    p.aggP = (float*)take((size_t)NB * NCH * DLRU * 4);
    p.aggE = (float*)take((size_t)NB * NCH * DLRU * 4);
    p.HB = (bf16_t*)take((size_t)T * Dm * 2);
    p.d1 = (bf16_t*)take((size_t)T * Dm * 2);
    p.d2 = (bf16_t*)take((size_t)T * Dm * 2);
    unsigned char* r1 = take(0);
    p.proj = (bf16_t*)take((size_t)T * NPROJ * 2);
    p.pooled = (bf16_t*)take((size_t)T * DLRU * 2);
    p.ycat = (bf16_t*)take((size_t)T * Dm * 2);
    p.act = (bf16_t*)r1;
    int ph_lo = 0, ph_hi = NPHASE;
    void* args[] = {&p, &ph_lo, &ph_hi};
    hipError_t e = hipLaunchCooperativeKernel((const void*)fwd_megakernel, dim3(grid_blocks), dim3(NTHREADS), args, (unsigned)LDS_BYTES, stream);
    if (e != hipSuccess) fprintf(stderr, "cooperative launch failed: %s (grid %d)\n", hipGetErrorString(e), grid_blocks);
}
```

```cpp
#include <hip/hip_runtime.h>
#include <hip/hip_cooperative_groups.h>
#include <cstdio>
#include <cstdint>
namespace cg = cooperative_groups;

#define LAS __attribute__((address_space(3)))
typedef unsigned short bf16_t;
typedef short bf16x8 __attribute__((ext_vector_type(8)));
typedef float f32x4 __attribute__((ext_vector_type(4)));
typedef unsigned u32x4 __attribute__((ext_vector_type(4)));
typedef unsigned u32x2 __attribute__((ext_vector_type(2)));

constexpr int Dm = 2048, NB = 2, SEQ = 16384, T = NB * SEQ, DLRU = 1024, NPROJ = 3072, DFF = 5632, NGU = 2 * DFF, NMOD = 6 * Dm;
constexpr int TC = 256, NCH = SEQ / TC;
constexpr int NTHREADS = 512, NWAVES = 8;
constexpr float EPS = 1e-6f;
constexpr float LOG2E = 1.4426950408889634f;

struct Params {
    const float *x, *c, *w_ada, *b_ada, *g_mix, *w_in, *w_conv, *b_conv, *w_rg_a, *b_rg_a, *w_rg_i, *b_rg_i, *lam, *w_pool, *ls_pool, *w_out, *g_ffn, *w_gate, *w_up, *w_down, *g_final;
    float* out;
    bf16_t *WinT, *WoutT, *WguT, *WdT, *WpT, *WAf;
    float *mod, *aggP, *aggE;
    bf16_t *HB, *proj, *pooled, *ycat, *act, *zbuf;
    bf16_t *d1, *d2;
    unsigned* bar;
};

__device__ __forceinline__ unsigned cvt_pk_bf16(float lo, float hi) { unsigned r; asm("v_cvt_pk_bf16_f32 %0, %1, %2" : "=v"(r) : "v"(lo), "v"(hi)); return r; }
__device__ __forceinline__ float bf_lo(unsigned w) { return __uint_as_float(w << 16); }
__device__ __forceinline__ float bf_hi(unsigned w) { return __uint_as_float(w & 0xffff0000u); }
__device__ __forceinline__ float fast_sigmoid(float v) { return __builtin_amdgcn_rcpf(1.0f + __builtin_amdgcn_exp2f(-LOG2E * v)); }
__device__ __forceinline__ float wave_sum(float v) {
#pragma unroll
    for (int o = 1; o < 64; o <<= 1) v += __shfl_xor(v, o);
    return v;
}

namespace pg8 {
constexpr int BM = 256, BK = 64, HALF = 128, HTB = HALF * BK * 2  , STAGE_BYTES = 8 * HTB, NXCD = 8, WGM = 8;

__host__ __device__ __forceinline__ int lds_byte(int r, int c) { const int st = (r >> 4) * 2 + (c >> 5), rr = r & 15, cc = c & 31, ob = rr * 64 + cc * 2; return st * 1024 + (ob ^ (((ob >> 9) & 1) << 5)); }
__host__ __device__ __forceinline__ void stage_rc(int b, int& R, int& C) { const int st = b / 1024, sb = b % 1024, swz = sb ^ (((sb >> 9) & 1) << 5); R = (st >> 1) * 16 + swz / 64; C = (st & 1) * 32 + (swz % 64) / 2; }
__host__ __device__ __forceinline__ int perm32(int rho) { const int n = rho >> 4, i = rho & 15; return 8 * (i >> 2) + 4 * n + (i & 3); }

struct Unit { int pm, pn; };
struct Gemm { const bf16_t* A; const bf16_t* Bt; int M, N, K, lda, ldb, a_pn_off; };

struct StaticOrder {
    int nM, nN, nwg, G, c;
    __host__ __device__ void init(int M, int N, int G_, int c_) { nM = M / BM; nN = N / BM; nwg = nM * nN; G = G_; c = c_; }
    __host__ __device__ bool next(int i, Unit& u) const {
        const long L = (long)i * G + c; if (L >= nwg) return false;
        int wgid = (int)L; { const int q = nwg / NXCD, r = nwg % NXCD, xcd = wgid % NXCD, off = wgid / NXCD; wgid = (xcd < r ? xcd * (q + 1) : r * (q + 1) + (xcd - r) * q) + off; }
        const int nig = WGM * nN, gid = wgid / nig, fm = gid * WGM, gsz = (nM - fm) < WGM ? (nM - fm) : WGM;
        u.pm = fm + ((wgid % nig) % gsz); u.pn = (wgid % nig) / gsz; return true;
    }
};

struct EpiBf16 {
    static constexpr bool PERM = true;
    bf16_t* O; int ldc;
    __device__ __forceinline__ void operator()(const f32x4 (&acc)[2][2][4][2], const Unit& u, int wr, int wc, int fr, int fq) const {
        const int row0 = u.pm * BM + wr * 64 + fr, col0 = u.pn * BM + wc * 32 + 8 * fq;
#pragma unroll
        for (int ai = 0; ai < 2; ++ai)
#pragma unroll
            for (int m = 0; m < 4; ++m) { bf16_t* rowp = O + (size_t)(row0 + ai * HALF + m * 16) * ldc + col0;
#pragma unroll
                for (int bj = 0; bj < 2; ++bj) { const f32x4 v0 = acc[ai][bj][m][0], v1 = acc[ai][bj][m][1];
                    u32x4 w; w.x = cvt_pk_bf16(v0[0], v0[1]); w.y = cvt_pk_bf16(v0[2], v0[3]); w.z = cvt_pk_bf16(v1[0], v1[1]); w.w = cvt_pk_bf16(v1[2], v1[3]);
                    *(u32x4*)(rowp + bj * HALF) = w; } }
    }
};
struct EpiGateBf16 {
    static constexpr bool PERM = true;
    bf16_t* O; const float* gate;
    __device__ __forceinline__ void operator()(const f32x4 (&acc)[2][2][4][2], const Unit& u, int wr, int wc, int fr, int fq) const {
        const int row0 = u.pm * BM + wr * 64 + fr, col0 = u.pn * BM + wc * 32 + 8 * fq;
        const float* gp = gate + (size_t)(u.pm >> 6) * NMOD + col0;
        f32x4 gv[2][2];
#pragma unroll
        for (int bj = 0; bj < 2; ++bj)
#pragma unroll
            for (int n = 0; n < 2; ++n) gv[bj][n] = *(const f32x4*)(gp + bj * HALF + n * 4);
#pragma unroll
        for (int ai = 0; ai < 2; ++ai)
#pragma unroll
            for (int m = 0; m < 4; ++m) { bf16_t* rowp = O + (size_t)(row0 + ai * HALF + m * 16) * Dm + col0;
#pragma unroll
                for (int bj = 0; bj < 2; ++bj) { const f32x4 v0 = acc[ai][bj][m][0] * gv[bj][0], v1 = acc[ai][bj][m][1] * gv[bj][1];
                    u32x4 w; w.x = cvt_pk_bf16(v0[0], v0[1]); w.y = cvt_pk_bf16(v0[2], v0[3]); w.z = cvt_pk_bf16(v1[0], v1[1]); w.w = cvt_pk_bf16(v1[2], v1[3]);
                    *(u32x4*)(rowp + bj * HALF) = w; } }
    }
};
struct EpiSwiglu {
    static constexpr bool PERM = true;
    bf16_t* O;
    __device__ __forceinline__ void operator()(const f32x4 (&acc)[2][2][4][2], const Unit& u, int wr, int wc, int fr, int fq) const {
        const int row0 = u.pm * BM + wr * 64 + fr, col0 = u.pn * HALF + wc * 32 + 8 * fq;
#pragma unroll
        for (int ai = 0; ai < 2; ++ai)
#pragma unroll
            for (int m = 0; m < 4; ++m) { bf16_t* rowp = O + (size_t)(row0 + ai * HALF + m * 16) * DFF + col0;
                f32x4 v0, v1;
#pragma unroll
                for (int j = 0; j < 4; ++j) { const float g0 = acc[ai][0][m][0][j], g1 = acc[ai][0][m][1][j];
                    v0[j] = g0 * fast_sigmoid(g0) * acc[ai][1][m][0][j]; v1[j] = g1 * fast_sigmoid(g1) * acc[ai][1][m][1][j]; }
                u32x4 w; w.x = cvt_pk_bf16(v0[0], v0[1]); w.y = cvt_pk_bf16(v0[2], v0[3]); w.z = cvt_pk_bf16(v1[0], v1[1]); w.w = cvt_pk_bf16(v1[2], v1[3]);
                __builtin_nontemporal_store(w, (u32x4*)rowp); }
    }
};

template <class Epi, class Sched, bool ALIGN_EPI = true>
__device__ __forceinline__ void gemm_phase(LAS unsigned char* lds, const Gemm g, const Sched& S, const Epi& E) {
    const int tid = threadIdx.x, wid = __builtin_amdgcn_readfirstlane(tid >> 6), lane = tid & 63, wr = wid >> 2, wc = wid & 3, fr = lane & 15, fq = lane >> 4;
    const int K = g.K, nt = K / BK;
    unsigned voffA[2], voffB[2];
#pragma unroll
    for (int i = 0; i < 2; ++i) { int R, C; stage_rc(tid * 16 + i * 8192, R, C); const int Rb = Epi::PERM ? ((R & ~31) + perm32(R & 31)) : R;
        voffA[i] = (unsigned)(R * g.lda + C) * 2u; voffB[i] = (unsigned)(Rb * g.ldb + C) * 2u; }
    const size_t kstep = (size_t)(BK * 2);
    const size_t hstepA = (size_t)HALF * g.lda * 2, hstepB = (size_t)HALF * g.ldb * 2;
    const size_t tstepA = 2 * hstepA, tstepB = 2 * hstepB;
    const unsigned ldsw = (unsigned)wid * 1024u;
    const int aoff = lds_byte(wr * 64 + fr, fq * 8), boff = lds_byte(wc * 32 + fr, fq * 8);
#define PG8_SA(b, h) (((b) * 2 + (h)) * HTB)
#define PG8_SB(b, h) ((4 + (b) * 2 + (h)) * HTB)
#define PG8_STAGE(bufoff, gbase, voff) do { _Pragma("unroll") for (int _i = 0; _i < 2; ++_i) \
        __builtin_amdgcn_global_load_lds((const unsigned*)((const char*)(gbase) + (voff)[_i]), (LAS unsigned*)(lds + (bufoff) + ldsw + _i * 8192), 16, 0, 0); } while (0)
#define PG8_LDA(dst, b, h) do { _Pragma("unroll") for (int m = 0; m < 4; ++m) _Pragma("unroll") for (int k = 0; k < 2; ++k) dst[m][k] = *(const LAS bf16x8*)(lds + PG8_SA(b, h) + aoff + m * 2048 + k * 1024); } while (0)
#define PG8_LDB(dst, b, h) do { _Pragma("unroll") for (int n = 0; n < 2; ++n) _Pragma("unroll") for (int k = 0; k < 2; ++k) dst[n][k] = *(const LAS bf16x8*)(lds + PG8_SB(b, h) + boff + n * 2048 + k * 1024); } while (0)
#define PG8_MMA(ai, bj, At, Bt) do { __builtin_amdgcn_s_setprio(1); _Pragma("unroll") for (int m = 0; m < 4; ++m) _Pragma("unroll") for (int n = 0; n < 2; ++n) _Pragma("unroll") for (int k = 0; k < 2; ++k) \
        acc[ai][bj][m][n] = __builtin_amdgcn_mfma_f32_16x16x32_bf16(Bt[n][k], At[m][k], acc[ai][bj][m][n], 0, 0, 0); __builtin_amdgcn_s_setprio(0); } while (0)
#define PG8_WAIT_V(n) asm volatile("s_waitcnt vmcnt(" #n ")" ::: "memory")
#define PG8_WAIT_L(n) asm volatile("s_waitcnt lgkmcnt(" #n ")" ::: "memory")
#define PG8_BAR __builtin_amdgcn_s_barrier()
#define PG8_SCHED __builtin_amdgcn_sched_barrier(0)
    Unit cur, nxt; int ui = 0;
    if (!S.next(0, cur)) return;
    f32x4 acc[2][2][4][2];
#pragma unroll
    for (int a = 0; a < 2; ++a)
#pragma unroll
        for (int b = 0; b < 2; ++b)
#pragma unroll
            for (int m = 0; m < 4; ++m)
#pragma unroll
                for (int n = 0; n < 2; ++n) acc[a][b][m][n] = (f32x4){0.f, 0.f, 0.f, 0.f};
    bf16x8 At[4][2], B0[2][2], B1[2][2];
    const char* cA = (const char*)g.A + (size_t)cur.pm * tstepA + (size_t)cur.pn * g.a_pn_off; const char* cB = (const char*)g.Bt + (size_t)cur.pn * tstepB;
    PG8_STAGE(PG8_SB(0, 0), cB, voffB); PG8_STAGE(PG8_SB(0, 1), cB + hstepB, voffB); PG8_STAGE(PG8_SA(0, 0), cA, voffA); PG8_STAGE(PG8_SA(0, 1), cA + hstepA, voffA);
    if (wr == 1) PG8_BAR;
    PG8_WAIT_V(2); PG8_BAR;
    PG8_STAGE(PG8_SB(1, 0), cB + kstep, voffB); PG8_STAGE(PG8_SA(1, 0), cA + kstep, voffA); PG8_STAGE(PG8_SB(1, 1), cB + hstepB + kstep, voffB);
    PG8_WAIT_V(6); PG8_BAR;
    for (;;) {
        const bool has_next = S.next(ui + 1, nxt);
        const char* nA = has_next ? (const char*)g.A + (size_t)nxt.pm * tstepA + (size_t)nxt.pn * g.a_pn_off : cA; const char* nB = has_next ? (const char*)g.Bt + (size_t)nxt.pn * tstepB : cB;
        for (int t = 0; t < nt; t += 2) {
            const bool last = (t == nt - 2);
            const char* a1 = cA + (size_t)(t + 1) * kstep;
            const char* a2 = last ? nA : cA + (size_t)(t + 2) * kstep; const char* b2 = last ? nB : cB + (size_t)(t + 2) * kstep;
            const char* a3 = a2 + kstep; const char* b3 = b2 + kstep;
            PG8_LDB(B0, 0, 0); PG8_LDB(B1, 0, 1); PG8_SCHED; PG8_LDA(At, 0, 0); PG8_STAGE(PG8_SA(1, 1), a1 + hstepA, voffA);
            PG8_WAIT_V(8); PG8_WAIT_L(0); PG8_BAR; PG8_MMA(0, 0, At, B0); PG8_MMA(0, 1, At, B1); PG8_BAR; PG8_SCHED;
            PG8_LDA(At, 0, 1); PG8_STAGE(PG8_SB(0, 0), b2, voffB); PG8_STAGE(PG8_SB(0, 1), b2 + hstepB, voffB); PG8_STAGE(PG8_SA(0, 0), a2, voffA);
            PG8_WAIT_V(8); PG8_WAIT_L(0); PG8_BAR; PG8_MMA(1, 0, At, B0); PG8_MMA(1, 1, At, B1); PG8_BAR; PG8_SCHED;
            PG8_LDB(B0, 1, 0); PG8_LDB(B1, 1, 1); PG8_SCHED; PG8_LDA(At, 1, 0); PG8_STAGE(PG8_SA(0, 1), a2 + hstepA, voffA);
            PG8_WAIT_V(8); PG8_WAIT_L(0); PG8_BAR; PG8_MMA(0, 0, At, B0); PG8_MMA(0, 1, At, B1); PG8_BAR; PG8_SCHED;
            PG8_LDA(At, 1, 1); PG8_STAGE(PG8_SB(1, 0), b3, voffB); PG8_STAGE(PG8_SB(1, 1), b3 + hstepB, voffB); PG8_STAGE(PG8_SA(1, 0), a3, voffA);
            PG8_WAIT_V(8); PG8_WAIT_L(0); PG8_BAR; PG8_MMA(1, 0, At, B0); PG8_MMA(1, 1, At, B1); PG8_BAR; PG8_SCHED;
        }
        if constexpr (ALIGN_EPI) { if (wr == 0) PG8_BAR; }
        E(acc, cur, wr, wc, fr, fq);
        if (!has_next) break;
#pragma unroll
        for (int a = 0; a < 2; ++a)
#pragma unroll
            for (int b = 0; b < 2; ++b)
#pragma unroll
                for (int m = 0; m < 4; ++m)
#pragma unroll
                    for (int n = 0; n < 2; ++n) acc[a][b][m][n] = (f32x4){0.f, 0.f, 0.f, 0.f};
        cur = nxt; cA = nA; cB = nB; ++ui;
        if constexpr (ALIGN_EPI) { if (wr == 1) PG8_BAR; }
    }
    PG8_WAIT_V(0);
    if constexpr (!ALIGN_EPI) { if (wr == 0) PG8_BAR; }
    PG8_BAR;
#undef PG8_SA
#undef PG8_SB
#undef PG8_STAGE
#undef PG8_LDA
#undef PG8_LDB
#undef PG8_MMA
#undef PG8_WAIT_V
#undef PG8_WAIT_L
#undef PG8_BAR
#undef PG8_SCHED
}
}

__device__ __forceinline__ void mod_task(const Params& p, LAS float* lds, int jg) {
    const int tid = threadIdx.x;
    LAS float* sc = lds;
    LAS float* red = lds + 4096;
    for (int i = tid; i < NB * Dm; i += NTHREADS) { const float v = p.c[i]; sc[i] = v * fast_sigmoid(v); }
    __syncthreads();
    const int c4 = tid & 31, ks = tid >> 5;
    const float* wp = p.w_ada + (size_t)(ks * 128) * NMOD + jg * 128 + c4 * 4;
    f32x4 a0 = (f32x4){0.f, 0.f, 0.f, 0.f}, a1 = a0;
#pragma unroll 16
    for (int kk = 0; kk < 128; ++kk) {
        const f32x4 w = __builtin_nontemporal_load((const f32x4*)(wp + (size_t)kk * NMOD));
        const float s0 = sc[ks * 128 + kk], s1 = sc[Dm + ks * 128 + kk];
        a0 += s0 * w; a1 += s1 * w;
    }
    *(LAS f32x4*)(red + (ks * 2 + 0) * 128 + c4 * 4) = a0;
    *(LAS f32x4*)(red + (ks * 2 + 1) * 128 + c4 * 4) = a1;
    __syncthreads();
    if (tid < 256) { const int b = tid >> 7, j = tid & 127; float s = p.b_ada[jg * 128 + j];
#pragma unroll
        for (int k2 = 0; k2 < 16; ++k2) s += red[(k2 * 2 + b) * 128 + j];
        p.mod[(size_t)b * NMOD + jg * 128 + j] = s; }
    __syncthreads();
}
__device__ __forceinline__ void transpose_item(const float* src, int N, bf16_t* dst, int ldd, int mode, const float* scale, int item, LAS float* scr, int lane) {
    const int nblk = N >> 5, kb = item / nblk, nb = item - kb * nblk, k0 = kb * 64, n0 = nb * 32;
    const float* s0 = src + (size_t)(k0 + (lane >> 3)) * N + n0 + (lane & 7) * 4;
    f32x4 v[8];
#pragma unroll
    for (int i = 0; i < 8; ++i) v[i] = __builtin_nontemporal_load((const f32x4*)(s0 + (size_t)(8 * i) * N));
    asm volatile("" ::: "memory"); __builtin_amdgcn_wave_barrier();
#pragma unroll
    for (int i = 0; i < 8; ++i) { LAS float* d = scr + (8 * i + (lane >> 3)) * 33 + (lane & 7) * 4; d[0] = v[i][0]; d[1] = v[i][1]; d[2] = v[i][2]; d[3] = v[i][3]; }
    asm volatile("" ::: "memory"); __builtin_amdgcn_wave_barrier();
    const int c = lane & 7;
#pragma unroll
    for (int j = 0; j < 4; ++j) { const int n = (lane >> 3) + 8 * j, nn = n0 + n; const LAS float* s = scr + (8 * c) * 33 + n;
        const float sc = scale ? scale[nn] : 1.0f;
        u32x4 o; o.x = cvt_pk_bf16(s[0] * sc, s[33] * sc); o.y = cvt_pk_bf16(s[2 * 33] * sc, s[3 * 33] * sc); o.z = cvt_pk_bf16(s[4 * 33] * sc, s[5 * 33] * sc); o.w = cvt_pk_bf16(s[6 * 33] * sc, s[7 * 33] * sc);
        const int drow = mode == 0 ? nn : (256 * (nn >> 7) + (nn & 127) + (mode == 2 ? 128 : 0));
        *(u32x4*)(dst + (size_t)drow * ldd + k0 + 8 * c) = o; }
    asm volatile("" ::: "memory"); __builtin_amdgcn_wave_barrier();
}
__device__ __forceinline__ void phase0(const Params& p, LAS float* lds) {
    const int G = gridDim.x, lane = threadIdx.x & 63, wave = threadIdx.x >> 6;
    constexpr int T_MOD = NMOD / 128;
    for (int task = blockIdx.x; task < T_MOD; task += G) mod_task(p, lds, task);
    constexpr int I_IN = (Dm / 64) * (NPROJ / 32), I_OUT = (Dm / 64) * (Dm / 32), I_G = (Dm / 64) * (DFF / 32), I_D = (DFF / 64) * (Dm / 32), I_P = 4 * 4 * 8;
    constexpr int NITEMS = I_IN + I_OUT + 2 * I_G + I_D + I_P, SKIP = 6;
    const int nmodb = G < T_MOD ? G : T_MOD, NW_NON = (G - nmodb) * NWAVES, NGW = G * NWAVES;
    const bool is_mod = (int)blockIdx.x < nmodb;
    const int vw = is_mod ? NW_NON + blockIdx.x * NWAVES + wave : (blockIdx.x - nmodb) * NWAVES + wave;
    const int skip = NW_NON > 0 ? SKIP : 0;
    LAS float* scr = lds + wave * (64 * 33);
    for (int r = 0;; ++r) {
        int it;
        if (r < skip) { if (is_mod) continue; it = r * NW_NON + vw; } else it = skip * NW_NON + (r - skip) * NGW + vw;
        if (it >= NITEMS) break;
        if (it < I_IN) { transpose_item(p.w_in, NPROJ, p.WinT, Dm, 0, nullptr, it, scr, lane); continue; } it -= I_IN;
        if (it < I_OUT) { transpose_item(p.w_out, Dm, p.WoutT, Dm, 0, nullptr, it, scr, lane); continue; } it -= I_OUT;
        if (it < I_G) { transpose_item(p.w_gate, DFF, p.WguT, Dm, 1, nullptr, it, scr, lane); continue; } it -= I_G;
        if (it < I_G) { transpose_item(p.w_up, DFF, p.WguT, Dm, 2, nullptr, it, scr, lane); continue; } it -= I_G;
        if (it < I_D) { transpose_item(p.w_down, Dm, p.WdT, DFF, 0, nullptr, it, scr, lane); continue; } it -= I_D;
        { const int gidx = it >> 5; transpose_item(p.w_pool + (size_t)gidx * 65536, 256, p.WpT + (size_t)gidx * 65536, 256, 0, p.ls_pool + gidx * 256, it & 31, scr, lane); }
    }
    for (int e = blockIdx.x * NTHREADS + threadIdx.x; e < 2 * 16 * 4096; e += G * NTHREADS) {
        const int el = e & 7, ln = (e >> 3) & 63, ks = (e >> 9) & 1, mt = (e >> 10) & 3, h = (e >> 12) & 15, gate = e >> 16;
        const int in = ks * 32 + (ln >> 4) * 8 + el, out = mt * 16 + (ln & 15);
        const float* w = gate ? p.w_rg_i : p.w_rg_a;
        p.WAf[e] = (bf16_t)(cvt_pk_bf16(w[(size_t)(h * 64 + in) * 64 + out], 0.f) & 0xffffu);
    }
}

template <int ND, bool FINAL>
__device__ __forceinline__ void phase_norm(const float* xin, const bf16_t* d1, const bf16_t* d2, const float* g, const float* sh, const float* sc, bf16_t* hb, float* outf) {
    const int lane = threadIdx.x & 63, wave = threadIdx.x >> 6;
    const int gw = blockIdx.x * NWAVES + wave, NGW = gridDim.x * NWAVES, rpw = (T + NGW - 1) / NGW;
    const int r0 = gw * rpw, r1 = (r0 + rpw < T) ? r0 + rpw : T;
    f32x4 fv[8], sv[8];
    int curb = -1;
    struct RowBuf { f32x4 v[8]; u32x2 a[8]; u32x2 c[8]; };
    auto load_row = [&](RowBuf& rb, const int row) __attribute__((always_inline)) {
        if (row < r1) {
#pragma unroll
            for (int j = 0; j < 8; ++j) { const size_t o = (size_t)row * Dm + j * 256 + lane * 4;
                rb.v[j] = __builtin_nontemporal_load((const f32x4*)(xin + o));
                if (ND >= 1) rb.a[j] = FINAL ? __builtin_nontemporal_load((const u32x2*)(d1 + o)) : *(const u32x2*)(d1 + o);
                if (ND >= 2) rb.c[j] = __builtin_nontemporal_load((const u32x2*)(d2 + o)); }
        }
    };
    auto do_row = [&](RowBuf& rb, const int row) __attribute__((always_inline)) {
        if (row >= r1) return;
        const int b = row >> 14;
        if (b != curb) { curb = b;
#pragma unroll
            for (int j = 0; j < 8; ++j) { const int k = j * 256 + lane * 4; const f32x4 gg = *(const f32x4*)(g + k);
                if (!FINAL) { const f32x4 s = *(const f32x4*)(sc + (size_t)b * NMOD + k); fv[j] = gg * (1.0f + s); sv[j] = *(const f32x4*)(sh + (size_t)b * NMOD + k); }
                else { fv[j] = gg; sv[j] = (f32x4){0.f, 0.f, 0.f, 0.f}; } } }
        float ss = 0.f;
#pragma unroll
        for (int j = 0; j < 8; ++j) {
            if (ND >= 1) { const u32x2 w = rb.a[j]; rb.v[j] += (f32x4){bf_lo(w.x), bf_hi(w.x), bf_lo(w.y), bf_hi(w.y)}; }
            if (ND >= 2) { const u32x2 w = rb.c[j]; rb.v[j] += (f32x4){bf_lo(w.x), bf_hi(w.x), bf_lo(w.y), bf_hi(w.y)}; }
            const f32x4 t = rb.v[j] * rb.v[j]; ss += (t[0] + t[1]) + (t[2] + t[3]);
        }
        ss = wave_sum(ss);
        const float rstd = 1.0f / sqrtf(ss * (1.0f / Dm) + EPS);
#pragma unroll
        for (int j = 0; j < 8; ++j) {
            const f32x4 o = rb.v[j] * rstd * fv[j] + sv[j];
            const size_t off = (size_t)row * Dm + j * 256 + lane * 4;
            if (!FINAL) { u32x2 w; w.x = cvt_pk_bf16(o[0], o[1]); w.y = cvt_pk_bf16(o[2], o[3]); *(u32x2*)(hb + off) = w; }
            else __builtin_nontemporal_store(o, (f32x4*)(outf + off));
        }
    };
    RowBuf A, B;
    load_row(A, r0);
#pragma unroll 1
    for (int row = r0; row < r1; row += 2) {
        load_row(B, row + 1); do_row(A, row);
        load_row(A, row + 2); do_row(B, row + 1);
    }
}

template <int CTRL> __device__ __forceinline__ float dppf(float oldv, float v) {
    return __builtin_bit_cast(float, __builtin_amdgcn_update_dpp(__builtin_bit_cast(int, oldv), __builtin_bit_cast(int, v), CTRL, 0xf, 0xf, false));
}
__device__ __forceinline__ void scan16x4(f32x4& a, f32x4& u) {
    float a0 = a[0], a1 = a[1], a2 = a[2], a3 = a[3], u0 = u[0], u1 = u[1], u2 = u[2], u3 = u[3];
#define SCAN_STEP(D) \
    "v_fmac_f32_dpp %4, %4, %0 row_shr:" #D " row_mask:0xf bank_mask:0xf\n" \
    "v_fmac_f32_dpp %5, %5, %1 row_shr:" #D " row_mask:0xf bank_mask:0xf\n" \
    "v_fmac_f32_dpp %6, %6, %2 row_shr:" #D " row_mask:0xf bank_mask:0xf\n" \
    "v_fmac_f32_dpp %7, %7, %3 row_shr:" #D " row_mask:0xf bank_mask:0xf\n" \
    "v_mul_f32_dpp %0, %0, %0 row_shr:" #D " row_mask:0xf bank_mask:0xf\n" \
    "v_mul_f32_dpp %1, %1, %1 row_shr:" #D " row_mask:0xf bank_mask:0xf\n" \
    "v_mul_f32_dpp %2, %2, %2 row_shr:" #D " row_mask:0xf bank_mask:0xf\n" \
    "v_mul_f32_dpp %3, %3, %3 row_shr:" #D " row_mask:0xf bank_mask:0xf\n"
    asm volatile("s_nop 4\n" SCAN_STEP(1) SCAN_STEP(2) SCAN_STEP(4) SCAN_STEP(8) "s_nop 1\n"
                 : "+v"(a0), "+v"(a1), "+v"(a2), "+v"(a3), "+v"(u0), "+v"(u1), "+v"(u2), "+v"(u3));
#undef SCAN_STEP
    a = (f32x4){a0, a1, a2, a3}; u = (f32x4){u0, u1, u2, u3};
}
constexpr int LMT = 2;
template <int VAR = 0>
__device__ __forceinline__ void lru_item(const Params& p, LAS float* tile  , int item) {
    const int lane = threadIdx.x & 63, fr = lane & 15, fq = lane >> 4;
    const int c = item & (NCH - 1), mg0 = ((item >> 6) & 1) * LMT, h = (item >> 7) & 15, b = item >> 11;
    const size_t rowbase = (size_t)b * SEQ;
    const int cch = h * 64 + 4 * fr;
    const f32x4 cw0 = *(const f32x4*)(p.w_conv + 0 * DLRU + cch), cw1 = *(const f32x4*)(p.w_conv + 1 * DLRU + cch), cw2 = *(const f32x4*)(p.w_conv + 2 * DLRU + cch), cw3 = *(const f32x4*)(p.w_conv + 3 * DLRU + cch);
    const f32x4 cbv = *(const f32x4*)(p.b_conv + cch);
    f32x4 ba[LMT], bi[LMT], cl[LMT];
    bf16x8 wa[LMT][2], wi[LMT][2];
#pragma unroll
    for (int mt = 0; mt < LMT; ++mt) { const int ch = h * 64 + (mg0 + mt) * 16 + fq * 4;
        ba[mt] = *(const f32x4*)(p.b_rg_a + ch); bi[mt] = *(const f32x4*)(p.b_rg_i + ch);
        const f32x4 lm = *(const f32x4*)(p.lam + ch);
#pragma unroll
        for (int j = 0; j < 4; ++j) { const float xl = lm[j]; cl[mt][j] = (8.0f * LOG2E) * (fminf(xl, 0.f) - log1pf(expf(-fabsf(xl)))); }
#pragma unroll
        for (int ks = 0; ks < 2; ++ks) {
            wa[mt][ks] = *(const bf16x8*)(p.WAf + ((size_t)(((0 * 16 + h) * 4 + mg0 + mt) * 2 + ks) * 64 + lane) * 8);
            wi[mt][ks] = *(const bf16x8*)(p.WAf + ((size_t)(((1 * 16 + h) * 4 + mg0 + mt) * 2 + ks) * 64 + lane) * 8); } }
    f32x4 st0[LMT], st1[LMT];
#pragma unroll
    for (int mt = 0; mt < LMT; ++mt) { st0[mt] = (f32x4){0.f, 0.f, 0.f, 0.f}; st1[mt] = (f32x4){1.f, 1.f, 1.f, 1.f}; }
    u32x2 raw[7]; u32x2 graw[LMT]; unsigned chk = 0;
    const bf16_t* xsrc = p.proj + (rowbase + (size_t)c * TC) * NPROJ + cch;
    const bf16_t* gsrc = p.proj + (rowbase + (size_t)c * TC + fr) * NPROJ + DLRU + h * 64 + mg0 * 16 + fq * 4;
#pragma unroll
    for (int i = 0; i < 7; ++i) { const int dt = 4 * fq - 3 + i;
        if (c * TC + dt >= 0) raw[i] = *(const u32x2*)(xsrc + (long)dt * NPROJ); else raw[i] = (u32x2){0u, 0u}; }
#pragma unroll
    for (int mt = 0; mt < LMT; ++mt) graw[mt] = *(const u32x2*)(gsrc + mt * 16);
    u32x2 rawB[7]; u32x2 grawB[LMT];
#pragma unroll
    for (int i = 0; i < 7; ++i) rawB[i] = *(const u32x2*)(xsrc + (size_t)16 * NPROJ + (long)(4 * fq - 3 + i) * NPROJ);
#pragma unroll
    for (int mt = 0; mt < LMT; ++mt) grawB[mt] = *(const u32x2*)(gsrc + (size_t)16 * NPROJ + mt * 16);
    auto tile_step = [&](const int nt, u32x2 (&raw)[7], u32x2 (&graw)[LMT]) __attribute__((always_inline)) {
        f32x4 xv[7];
#pragma unroll
        for (int i = 0; i < 7; ++i) xv[i] = (f32x4){bf_lo(raw[i].x), bf_hi(raw[i].x), bf_lo(raw[i].y), bf_hi(raw[i].y)};
        f32x4 gg[LMT];
#pragma unroll
        for (int mt = 0; mt < LMT; ++mt) gg[mt] = (f32x4){bf_lo(graw[mt].x), bf_hi(graw[mt].x), bf_lo(graw[mt].y), bf_hi(graw[mt].y)};
        if (!(VAR & 2) && nt + 2 < TC / 16) {
            const bf16_t* xn = xsrc + (size_t)(nt + 2) * 16 * NPROJ;
#pragma unroll
            for (int i = 0; i < 7; ++i) raw[i] = *(const u32x2*)(xn + (long)(4 * fq - 3 + i) * NPROJ);
#pragma unroll
            for (int mt = 0; mt < LMT; ++mt) graw[mt] = *(const u32x2*)(gsrc + (size_t)(nt + 2) * 16 * NPROJ + mt * 16);
        }
        asm volatile("" ::: "memory"); __builtin_amdgcn_wave_barrier();
#pragma unroll
        for (int j = 0; j < 4; ++j) { const f32x4 xc = cbv + cw0 * xv[j] + cw1 * xv[j + 1] + cw2 * xv[j + 2] + cw3 * xv[j + 3];
            *(LAS f32x4*)(tile + (4 * fq + j) * 68 + 4 * fr) = xc; }
        asm volatile("" ::: "memory"); __builtin_amdgcn_wave_barrier();
        bf16x8 bfr[2]; f32x4 xd[LMT];
#pragma unroll
        for (int ks = 0; ks < 2; ++ks) { const f32x4 lo = *(const LAS f32x4*)(tile + fr * 68 + ks * 32 + fq * 8), hi = *(const LAS f32x4*)(tile + fr * 68 + ks * 32 + fq * 8 + 4);
            u32x4 w; w.x = cvt_pk_bf16(lo[0], lo[1]); w.y = cvt_pk_bf16(lo[2], lo[3]); w.z = cvt_pk_bf16(hi[0], hi[1]); w.w = cvt_pk_bf16(hi[2], hi[3]);
            bfr[ks] = __builtin_bit_cast(bf16x8, w); }
#pragma unroll
        for (int mt = 0; mt < LMT; ++mt) xd[mt] = *(const LAS f32x4*)(tile + fr * 68 + (mg0 + mt) * 16 + fq * 4);
        asm volatile("" ::: "memory"); __builtin_amdgcn_wave_barrier();
        const size_t trow = rowbase + (size_t)c * TC + nt * 16 + fr;
#pragma unroll
        for (int mt = 0; mt < LMT; ++mt) {
            f32x4 dr = (f32x4){0.f, 0.f, 0.f, 0.f}, di = dr;
            dr = __builtin_amdgcn_mfma_f32_16x16x32_bf16(wa[mt][0], bfr[0], dr, 0, 0, 0); dr = __builtin_amdgcn_mfma_f32_16x16x32_bf16(wa[mt][1], bfr[1], dr, 0, 0, 0);
            di = __builtin_amdgcn_mfma_f32_16x16x32_bf16(wi[mt][0], bfr[0], di, 0, 0, 0); di = __builtin_amdgcn_mfma_f32_16x16x32_bf16(wi[mt][1], bfr[1], di, 0, 0, 0);
            f32x4 av, uv;
#pragma unroll
            for (int j = 0; j < 4; ++j) {
                const float r = fast_sigmoid(dr[j] + ba[mt][j]), ig = fast_sigmoid(di[j] + bi[mt][j]);
                const float a = __builtin_amdgcn_exp2f(r * cl[mt][j]);
                av[j] = a; uv[j] = __builtin_amdgcn_sqrtf(1.0f - a * a) * ig * xd[mt][j];
            }
            scan16x4(av, uv);
            const int ch = h * 64 + (mg0 + mt) * 16 + fq * 4;
            f32x4 y, z;
#pragma unroll
            for (int j = 0; j < 4; ++j) { const float hh = fmaf(av[j], st0[mt][j], uv[j]), zz = av[j] * st1[mt][j];
                st0[mt][j] = __shfl(hh, lane | 15); st1[mt][j] = __shfl(zz, lane | 15);
                const float gx = gg[mt][j]; const float ge = gx * fast_sigmoid(1.5957691216057308f * (gx + 0.044715f * gx * gx * gx));
                y[j] = hh * ge; z[j] = zz * ge; }
            u32x2 w; w.x = cvt_pk_bf16(y[0], y[1]); w.y = cvt_pk_bf16(y[2], y[3]);
            u32x2 w2; w2.x = cvt_pk_bf16(z[0], z[1]); w2.y = cvt_pk_bf16(z[2], z[3]);
            if (!(VAR & 1)) { *(u32x4*)(p.zbuf + trow * (2 * DLRU) + 2 * ch) = (u32x4){w.x, w.y, w2.x, w2.y}; }
            else chk += (w.x ^ w.y) + (w2.x ^ w2.y);
        }
    };
#pragma unroll 1
    for (int nt = 0; nt < TC / 16; nt += 2) { tile_step(nt, raw, graw); tile_step(nt + 1, rawB, grawB); }
    if (VAR) { if (chk == 0x12345u && st0[0][0] == 3.25f) p.aggE[0] = 1.0f; return; }
    if (fr == 15) {
#pragma unroll
        for (int mt = 0; mt < LMT; ++mt) { const size_t o = ((size_t)(b * NCH + c)) * DLRU + h * 64 + (mg0 + mt) * 16 + fq * 4;
            *(f32x4*)(p.aggE + o) = st0[mt]; *(f32x4*)(p.aggP + o) = st1[mt]; }
    }
}
__device__ __forceinline__ void lru_fixup(const Params& p, int item) {
    const int lane = threadIdx.x & 63, q = lane & 15;
    const int c = item & (NCH - 1), h = (item >> 6) & 15, b = item >> 10;
    float hin = 0.f;
    { const float* pP = p.aggP + (size_t)(b * NCH) * DLRU + h * 64 + lane; const float* pE = p.aggE + (size_t)(b * NCH) * DLRU + h * 64 + lane;
#pragma unroll 8
      for (int cc = 0; cc < c; ++cc) hin = pP[(size_t)cc * DLRU] * hin + pE[(size_t)cc * DLRU]; }
    float cy[4];
#pragma unroll
    for (int e = 0; e < 4; ++e) cy[e] = __shfl(hin, q * 4 + e);
    const size_t row0 = (size_t)b * SEQ + (size_t)c * TC + (lane >> 4);
    bf16_t* yp = p.ycat + row0 * Dm + h * 64 + q * 4;
    const bf16_t* zp = p.zbuf + row0 * (2 * DLRU) + (h * 64 + q * 4) * 2;
#pragma unroll 8
    for (int i = 0; i < TC / 4; ++i) {
        const u32x4 w = __builtin_nontemporal_load((const u32x4*)(zp + (size_t)(4 * i) * (2 * DLRU)));
        u32x2 o;
        o.x = cvt_pk_bf16(fmaf(bf_lo(w.z), cy[0], bf_lo(w.x)), fmaf(bf_hi(w.z), cy[1], bf_hi(w.x)));
        o.y = cvt_pk_bf16(fmaf(bf_lo(w.w), cy[2], bf_lo(w.y)), fmaf(bf_hi(w.w), cy[3], bf_hi(w.y)));
        *(u32x2*)(yp + (size_t)(4 * i) * Dm) = o;
    }
}
template <int W>
__device__ __forceinline__ void pool_block(const Params& p, int b, int gidx, int t0) {
    const int lane = threadIdx.x & 63;
    const bf16_t* src = p.proj + ((size_t)b * SEQ) * NPROJ + 2 * DLRU + gidx * 256 + lane * 4;
    bf16_t* dst = p.pooled + ((size_t)b * SEQ) * DLRU + gidx * 256 + lane * 4;
    u32x2 pre[W - 1], rw[2][16];
#pragma unroll
    for (int k = 0; k < W - 1; ++k) { const int tk = t0 - W + 1 + k; pre[k] = (u32x2){0u, 0u}; if (tk >= 0) pre[k] = __builtin_nontemporal_load((const u32x2*)(src + (size_t)tk * NPROJ)); }
#pragma unroll
    for (int ii = 0; ii < 16; ++ii) rw[0][ii] = __builtin_nontemporal_load((const u32x2*)(src + (size_t)(t0 + ii) * NPROJ));
    f32x4 ring[W]; f32x4 S = (f32x4){0.f, 0.f, 0.f, 0.f};
#pragma unroll
    for (int k = 0; k < W - 1; ++k) { const f32x4 v = (f32x4){bf_lo(pre[k].x), bf_hi(pre[k].x), bf_lo(pre[k].y), bf_hi(pre[k].y)}; ring[k] = v; S += v; }
    ring[W - 1] = (f32x4){0.f, 0.f, 0.f, 0.f};
#pragma unroll
    for (int grp = 0; grp < 4; ++grp) {
        if (grp + 1 < 4) {
#pragma unroll
            for (int ii = 0; ii < 16; ++ii) rw[(grp + 1) & 1][ii] = __builtin_nontemporal_load((const u32x2*)(src + (size_t)(t0 + (grp + 1) * 16 + ii) * NPROJ));
        }
#pragma unroll
        for (int ii = 0; ii < 16; ++ii) { const int t = t0 + grp * 16 + ii; const u32x2 r = rw[grp & 1][ii];
            const f32x4 x = (f32x4){bf_lo(r.x), bf_hi(r.x), bf_lo(r.y), bf_hi(r.y)};
            S += x;
            const float inv = (t + 1 < W) ? __builtin_amdgcn_rcpf((float)(t + 1)) : 1.0f / (float)W;
            const f32x4 o = S * inv - x;
            u32x2 w; w.x = cvt_pk_bf16(o[0], o[1]); w.y = cvt_pk_bf16(o[2], o[3]);
            *(u32x2*)(dst + (size_t)t * DLRU) = w;
            S -= ring[ii % W]; ring[(ii + W - 1) % W] = x; }
    }
}
__device__ __forceinline__ void pool_items(const Params& p) {
    const int wave = threadIdx.x >> 6;
    const int gw = blockIdx.x * NWAVES + wave, NGW = gridDim.x * NWAVES;
    for (int item = gw; item < NB * 4 * (SEQ / 64); item += NGW) {
        const int gidx = item & 3, blk = (item >> 2) & (SEQ / 64 - 1), b = item >> 10;
        if (gidx == 0) pool_block<2>(p, b, 0, blk * 64);
        else if (gidx == 1) pool_block<4>(p, b, 1, blk * 64);
        else if (gidx == 2) pool_block<8>(p, b, 2, blk * 64);
        else pool_block<16>(p, b, 3, blk * 64);
    }
}

#define XB_TMO      128
#define XB_XCNT(j)  (256  + 64 * (j))
#define XB_XSUB(j)  (1280 + 64 * (j))
#define XB_XGEN(j)  (2304 + 64 * (j))
#define XB_TOP      3328
#define XB_TOPGEN   3392
#define XCD_BAR_WORDS 3456
#define XB_SPIN_CAP (1u << 18)
__device__ __forceinline__ unsigned xb_ld(unsigned* p)              { return __hip_atomic_load(p, __ATOMIC_RELAXED, __HIP_MEMORY_SCOPE_AGENT); }
__device__ __forceinline__ unsigned xb_add(unsigned* p, unsigned v) { return __hip_atomic_fetch_add(p, v, __ATOMIC_RELAXED, __HIP_MEMORY_SCOPE_AGENT); }
__device__ __forceinline__ unsigned xb_xcc_id() { return (unsigned)__builtin_amdgcn_s_getreg((3 << 11) | 20) & 0xFu; }
#define XB_SPIN(cond, bar) do { unsigned _sp = 0; while (cond) { __builtin_amdgcn_s_sleep(1); \
    if ((++_sp & 255u) == 0u) { if (xb_ld(&(bar)[XB_TMO])) break; if (_sp > XB_SPIN_CAP) { atomicAdd(&(bar)[XB_TMO], 1u); break; } } } } while (0)
struct XcdBarrier { unsigned* bar; unsigned x; volatile LAS unsigned* st; };
__device__ __forceinline__ XcdBarrier xcd_barrier_post(unsigned* bar, volatile LAS unsigned* st) {
    XcdBarrier b; b.bar = bar; b.x = xb_xcc_id(); b.st = st;
    if (threadIdx.x == 0) (void)xb_add(&bar[XB_XCNT(b.x)], 1u);
    return b;
}
__device__ __forceinline__ void xcd_barrier_complete(unsigned* bar, unsigned x, unsigned& nloc, unsigned& nx) {
    const unsigned G = gridDim.x * gridDim.y * gridDim.z;
    unsigned sum, cnt, mine, sp = 0u;
    for (;;) {
        sum = 0u; cnt = 0u; mine = 0u;
#pragma unroll
        for (unsigned j = 0; j < 16; ++j) { const unsigned c = xb_ld(&bar[XB_XCNT(j)]); sum += c; cnt += (c > 0u) ? 1u : 0u; mine = (j == x) ? c : mine; }
        if (sum == G) break;
        __builtin_amdgcn_s_sleep(1);
        if ((++sp & 255u) == 0u) { if (xb_ld(&bar[XB_TMO])) break; if (sp > XB_SPIN_CAP) { atomicAdd(&bar[XB_TMO], 1u); break; } }
    }
    nloc = mine > 0u ? mine : 1u; nx = cnt > 0u ? cnt : 1u;
}
__device__ __forceinline__ void xcd_barrier(const XcdBarrier& b) {
    asm volatile("s_waitcnt vmcnt(0)" ::: "memory");
    __syncthreads();
    if (threadIdx.x == 0) {
        unsigned* bar = b.bar;
        __builtin_amdgcn_s_waitcnt(0);
        unsigned nloc = b.st[0], nx = b.st[1];
        if (nloc == 0u) { xcd_barrier_complete(bar, b.x, nloc, nx); b.st[0] = nloc; b.st[1] = nx; }
        const unsigned old = xb_add(&bar[XB_XSUB(b.x)], 1u);
        const unsigned gen = old / nloc;
        if (old + 1u == (gen + 1u) * nloc) {
            __builtin_amdgcn_fence(__ATOMIC_RELEASE, "agent");
            asm volatile("s_waitcnt vmcnt(0)" ::: "memory");
            const unsigned og = xb_add(&bar[XB_TOP], 1u);
            const unsigned tg = og / nx;
            if (og + 1u == (tg + 1u) * nx) xb_add(&bar[XB_TOPGEN], 1u);
            else XB_SPIN(xb_ld(&bar[XB_TOPGEN]) == tg, bar);
            __builtin_amdgcn_fence(__ATOMIC_ACQUIRE, "agent");
            xb_add(&bar[XB_XGEN(b.x)], 1u);
            asm volatile("s_waitcnt vmcnt(0)" ::: "memory");
        } else {
            XB_SPIN(xb_ld(&bar[XB_XGEN(b.x)]) == gen, bar);
            __builtin_amdgcn_fence(__ATOMIC_ACQUIRE, "agent");
            asm volatile("s_waitcnt vmcnt(0)" ::: "memory");
        }
    }
    __syncthreads();
}

constexpr int NPHASE = 10;
#ifndef PHMASK
#define PHMASK 0x3ff
#endif
#define PH_ON(k) (((PHMASK) >> (k)) & 1)
#define SYNC_BEFORE(k) if (ph_lo < (k) && (k) < ph_hi) xcd_barrier(xb);
#ifndef PROBE_SUB
#define PROBE_SUB 0
#endif
#ifndef DUPMASK
#define DUPMASK 0
#endif
#define NREP(k) ((((DUPMASK) >> (k)) & 1) ? 2 : 1)
template <int K>
__device__ __forceinline__ void run_phase(const Params& p, LAS unsigned char* lds) {
    const int G = gridDim.x, wave = threadIdx.x >> 6;
    if constexpr (K == 0) { phase0(p, (LAS float*)lds); }
    if constexpr (K == 1) { phase_norm<0, false>(p.x, nullptr, nullptr, p.g_mix, p.mod + 0 * Dm, p.mod + 1 * Dm, p.HB, nullptr); }
    if constexpr (K == 2) { pg8::Gemm g{p.HB, p.WinT, T, NPROJ, Dm, Dm, Dm, 0}; pg8::StaticOrder S; S.init(T, NPROJ, G, blockIdx.x); pg8::EpiBf16 E{p.proj, NPROJ};
        pg8::gemm_phase<pg8::EpiBf16, pg8::StaticOrder>(lds, g, S, E); }
    if constexpr (K == 3) {
#pragma unroll 1
        for (int s = 0; s < 2; ++s) {
            if (((s ^ (wave >> 2)) & 1) == 0) { for (int item = blockIdx.x * NWAVES + wave; item < NB * 16 * (4 / LMT) * NCH; item += G * NWAVES) lru_item(p, (LAS float*)lds + wave * (16 * 68), item); }
            else pool_items(p);
        } }
    if constexpr (K == 4) {
        const bool fix_first = ((blockIdx.x >> 3) & 1) == 0;
        if (fix_first) { for (int item = blockIdx.x * NWAVES + wave; item < NB * 16 * NCH; item += G * NWAVES) lru_fixup(p, item); }
        pg8::Gemm g{p.pooled, p.WpT, T, DLRU, 256, DLRU, 256, 512}; pg8::StaticOrder S; S.init(T, DLRU, G, blockIdx.x); pg8::EpiBf16 E{p.ycat + DLRU, Dm};
        pg8::gemm_phase<pg8::EpiBf16, pg8::StaticOrder>(lds, g, S, E);
        if (!fix_first) { for (int item = blockIdx.x * NWAVES + wave; item < NB * 16 * NCH; item += G * NWAVES) lru_fixup(p, item); } }
    if constexpr (K == 5) { pg8::Gemm g{p.ycat, p.WoutT, T, Dm, Dm, Dm, Dm, 0}; pg8::StaticOrder S; S.init(T, Dm, G, blockIdx.x); pg8::EpiGateBf16 E{p.d1, p.mod + 2 * Dm};
        pg8::gemm_phase<pg8::EpiGateBf16, pg8::StaticOrder>(lds, g, S, E); }
    if constexpr (K == 6) { phase_norm<1, false>(p.x, p.d1, nullptr, p.g_ffn, p.mod + 3 * Dm, p.mod + 4 * Dm, p.HB, nullptr); }
    if constexpr (K == 7) { pg8::Gemm g{p.HB, p.WguT, T, NGU, Dm, Dm, Dm, 0}; pg8::StaticOrder S; S.init(T, NGU, G, blockIdx.x); pg8::EpiSwiglu E{p.act};
        pg8::gemm_phase<pg8::EpiSwiglu, pg8::StaticOrder>(lds, g, S, E); }
    if constexpr (K == 8) { pg8::Gemm g{p.act, p.WdT, T, Dm, DFF, DFF, DFF, 0}; pg8::StaticOrder S; S.init(T, Dm, G, blockIdx.x); pg8::EpiGateBf16 E{p.d2, p.mod + 5 * Dm};
        pg8::gemm_phase<pg8::EpiGateBf16, pg8::StaticOrder>(lds, g, S, E); }
    if constexpr (K == 9) { phase_norm<2, true>(p.x, p.d1, p.d2, p.g_final, nullptr, nullptr, nullptr, p.out); }
}
#define DO_PHASE(k) SYNC_BEFORE(k) if (PH_ON(k) && ph_lo <= (k) && (k) < ph_hi) { run_phase<k>(p, lds); if (NREP(k) > 1) { xcd_barrier(xb); run_phase<k>(p, lds); } }
__global__ void __launch_bounds__(NTHREADS, 2) fwd_megakernel(Params p, int ph_lo, int ph_hi) {
    extern __shared__ __attribute__((aligned(16))) unsigned char shm[];
    LAS unsigned char* lds = (LAS unsigned char*)shm;
    cg::grid_group grid = cg::this_grid();
    __shared__ uint4 xb_words;
    if (threadIdx.x == 0) xb_words = make_uint4(0u, 0u, 0u, 0u);
    __syncthreads();
    const XcdBarrier xb = xcd_barrier_post(p.bar, (volatile LAS unsigned*)&xb_words);
    if (ph_lo == 0x7fffffff) grid.sync();
    DO_PHASE(0) DO_PHASE(1) DO_PHASE(2) DO_PHASE(3) DO_PHASE(4) DO_PHASE(5) DO_PHASE(6) DO_PHASE(7) DO_PHASE(8) DO_PHASE(9)
}

extern "C" void kernel_launch(void* const* d_in, const int* in_sizes, int n_in, void* d_out, int out_size, void* d_ws, size_t ws_size, hipStream_t stream) {
    constexpr size_t LDS_BYTES = pg8::STAGE_BYTES;
    static int grid_blocks = 0;
    if (!grid_blocks) {
        int dev = 0, cus = 0, per_cu = 0;
        hipGetDevice(&dev);
        hipDeviceGetAttribute(&cus, hipDeviceAttributeMultiprocessorCount, dev);
        hipFuncSetAttribute((const void*)fwd_megakernel, hipFuncAttributeMaxDynamicSharedMemorySize, (int)LDS_BYTES);
        hipOccupancyMaxActiveBlocksPerMultiprocessor(&per_cu, (const void*)fwd_megakernel, NTHREADS, LDS_BYTES);
        per_cu = 1;
        if (cus < 1) cus = 256;
        grid_blocks = cus * per_cu;
    }
    Params p{};
    const float* const* in = (const float* const*)d_in;
    p.x = in[0]; p.c = in[1]; p.w_ada = in[2]; p.b_ada = in[3]; p.g_mix = in[4]; p.w_in = in[5]; p.w_conv = in[6]; p.b_conv = in[7];
    p.w_rg_a = in[8]; p.b_rg_a = in[9]; p.w_rg_i = in[10]; p.b_rg_i = in[11]; p.lam = in[12]; p.w_pool = in[13]; p.ls_pool = in[14];
    p.w_out = in[15]; p.g_ffn = in[16]; p.w_gate = in[17]; p.w_up = in[18]; p.w_down = in[19]; p.g_final = in[20];
    p.out = (float*)d_out;
    unsigned char* ws = (unsigned char*)d_ws; size_t off = 0;
    auto take = [&](size_t bytes) { unsigned char* r = ws + off; off += (bytes + 255) & ~(size_t)255; return r; };
    p.bar = (unsigned*)take((size_t)XCD_BAR_WORDS * 4);
    p.WinT = (bf16_t*)take((size_t)NPROJ * Dm * 2);
    p.WoutT = (bf16_t*)take((size_t)Dm * Dm * 2);
    p.WguT = (bf16_t*)take((size_t)NGU * Dm * 2);
    p.WdT = (bf16_t*)take((size_t)Dm * DFF * 2);
    p.WpT = (bf16_t*)take((size_t)DLRU * 256 * 2);
    p.WAf = (bf16_t*)take((size_t)2 * 16 * 4096 * 2);
    p.mod = (float*)take((size_t)NB * NMOD * 4);
    p.aggP = (float*)take((size_t)NB * NCH * DLRU * 4);
    p.aggE = (float*)take((size_t)NB * NCH * DLRU * 4);
    p.HB = (bf16_t*)take((size_t)T * Dm * 2);
    p.d1 = (bf16_t*)take((size_t)T * Dm * 2);
    p.d2 = (bf16_t*)take((size_t)T * Dm * 2);
    unsigned char* r1 = take(0);
    p.proj = (bf16_t*)take((size_t)T * NPROJ * 2);
    p.pooled = (bf16_t*)take((size_t)T * DLRU * 2);
    p.ycat = (bf16_t*)take((size_t)T * Dm * 2);
    p.act = (bf16_t*)r1;
    p.zbuf = p.HB;
    (void)hipMemsetAsync(p.bar, 0, (size_t)XCD_BAR_WORDS * 4, stream);
    int ph_lo = 0, ph_hi = NPHASE;
    void* args[] = {&p, &ph_lo, &ph_hi};
    hipError_t e = hipLaunchCooperativeKernel((const void*)fwd_megakernel, dim3(grid_blocks), dim3(NTHREADS), args, (unsigned)LDS_BYTES, stream);
    if (e != hipSuccess) fprintf(stderr, "cooperative launch failed: %s (grid %d)\n", hipGetErrorString(e), grid_blocks);
}
```

```cpp
#include <hip/hip_runtime.h>
#include <hip/hip_cooperative_groups.h>
#include <cstdio>
#include <cstdint>
namespace cg = cooperative_groups;

#define LAS __attribute__((address_space(3)))
typedef unsigned short bf16_t;
typedef short bf16x8 __attribute__((ext_vector_type(8)));
typedef float f32x4 __attribute__((ext_vector_type(4)));
typedef unsigned u32x4 __attribute__((ext_vector_type(4)));
typedef unsigned u32x2 __attribute__((ext_vector_type(2)));

constexpr int Dm = 2048, NB = 2, SEQ = 16384, T = NB * SEQ, DLRU = 1024, NPROJ = 3072, DFF = 5632, NGU = 2 * DFF, NMOD = 6 * Dm;
constexpr int TC = 256, NCH = SEQ / TC;
constexpr int NTHREADS = 512, NWAVES = 8;
constexpr float EPS = 1e-6f;
constexpr float LOG2E = 1.4426950408889634f;

struct Params {
    const float *x, *c, *w_ada, *b_ada, *g_mix, *w_in, *w_conv, *b_conv, *w_rg_a, *b_rg_a, *w_rg_i, *b_rg_i, *lam, *w_pool, *ls_pool, *w_out, *g_ffn, *w_gate, *w_up, *w_down, *g_final;
    float* out;
    bf16_t *WinT, *WoutT, *WguT, *WdT, *WpT, *WAf;
    float *mod, *aggP, *aggE;
    bf16_t *HB, *proj, *pooled, *ycat, *act, *zbuf;
    bf16_t *d1, *d2;
    unsigned* bar;
};

__device__ __forceinline__ unsigned cvt_pk_bf16(float lo, float hi) { unsigned r; asm("v_cvt_pk_bf16_f32 %0, %1, %2" : "=v"(r) : "v"(lo), "v"(hi)); return r; }
__device__ __forceinline__ float bf_lo(unsigned w) { return __uint_as_float(w << 16); }
__device__ __forceinline__ float bf_hi(unsigned w) { return __uint_as_float(w & 0xffff0000u); }
__device__ __forceinline__ float fast_sigmoid(float v) { return __builtin_amdgcn_rcpf(1.0f + __builtin_amdgcn_exp2f(-LOG2E * v)); }
__device__ __forceinline__ float wave_sum(float v) {
#pragma unroll
    for (int o = 1; o < 64; o <<= 1) v += __shfl_xor(v, o);
    return v;
}

namespace pg8 {
constexpr int BM = 256, BK = 64, HALF = 128, HTB = HALF * BK * 2  , STAGE_BYTES = 8 * HTB, NXCD = 8, WGM = 8;

__host__ __device__ __forceinline__ int lds_byte(int r, int c) { const int st = (r >> 4) * 2 + (c >> 5), rr = r & 15, cc = c & 31, ob = rr * 64 + cc * 2; return st * 1024 + (ob ^ (((ob >> 9) & 1) << 5)); }
__host__ __device__ __forceinline__ void stage_rc(int b, int& R, int& C) { const int st = b / 1024, sb = b % 1024, swz = sb ^ (((sb >> 9) & 1) << 5); R = (st >> 1) * 16 + swz / 64; C = (st & 1) * 32 + (swz % 64) / 2; }
__host__ __device__ __forceinline__ int perm32(int rho) { const int n = rho >> 4, i = rho & 15; return 8 * (i >> 2) + 4 * n + (i & 3); }

struct Unit { int pm, pn; };
struct Gemm { const bf16_t* A; const bf16_t* Bt; int M, N, K, lda, ldb, a_pn_off; };

struct StaticOrder {
    int nM, nN, nwg, G, c;
    __host__ __device__ void init(int M, int N, int G_, int c_) { nM = M / BM; nN = N / BM; nwg = nM * nN; G = G_; c = c_; }
    __host__ __device__ bool next(int i, Unit& u) const {
        const long L = (long)i * G + c; if (L >= nwg) return false;
        int wgid = (int)L; { const int q = nwg / NXCD, r = nwg % NXCD, xcd = wgid % NXCD, off = wgid / NXCD; wgid = (xcd < r ? xcd * (q + 1) : r * (q + 1) + (xcd - r) * q) + off; }
        const int nig = WGM * nN, gid = wgid / nig, fm = gid * WGM, gsz = (nM - fm) < WGM ? (nM - fm) : WGM;
        u.pm = fm + ((wgid % nig) % gsz); u.pn = (wgid % nig) / gsz; return true;
    }
};

struct EpiBf16 {
    static constexpr bool PERM = true;
    bf16_t* O; int ldc;
    __device__ __forceinline__ void operator()(const f32x4 (&acc)[2][2][4][2], const Unit& u, int wr, int wc, int fr, int fq) const {
        const int row0 = u.pm * BM + wr * 64 + fr, col0 = u.pn * BM + wc * 32 + 8 * fq;
#pragma unroll
        for (int ai = 0; ai < 2; ++ai)
#pragma unroll
            for (int m = 0; m < 4; ++m) { bf16_t* rowp = O + (size_t)(row0 + ai * HALF + m * 16) * ldc + col0;
#pragma unroll
                for (int bj = 0; bj < 2; ++bj) { const f32x4 v0 = acc[ai][bj][m][0], v1 = acc[ai][bj][m][1];
                    u32x4 w; w.x = cvt_pk_bf16(v0[0], v0[1]); w.y = cvt_pk_bf16(v0[2], v0[3]); w.z = cvt_pk_bf16(v1[0], v1[1]); w.w = cvt_pk_bf16(v1[2], v1[3]);
                    *(u32x4*)(rowp + bj * HALF) = w; } }
    }
};
struct EpiGateBf16 {
    static constexpr bool PERM = true;
    bf16_t* O; const float* gate;
    __device__ __forceinline__ void operator()(const f32x4 (&acc)[2][2][4][2], const Unit& u, int wr, int wc, int fr, int fq) const {
        const int row0 = u.pm * BM + wr * 64 + fr, col0 = u.pn * BM + wc * 32 + 8 * fq;
        const float* gp = gate + (size_t)(u.pm >> 6) * NMOD + col0;
        f32x4 gv[2][2];
#pragma unroll
        for (int bj = 0; bj < 2; ++bj)
#pragma unroll
            for (int n = 0; n < 2; ++n) gv[bj][n] = *(const f32x4*)(gp + bj * HALF + n * 4);
#pragma unroll
        for (int ai = 0; ai < 2; ++ai)
#pragma unroll
            for (int m = 0; m < 4; ++m) { bf16_t* rowp = O + (size_t)(row0 + ai * HALF + m * 16) * Dm + col0;
#pragma unroll
                for (int bj = 0; bj < 2; ++bj) { const f32x4 v0 = acc[ai][bj][m][0] * gv[bj][0], v1 = acc[ai][bj][m][1] * gv[bj][1];
                    u32x4 w; w.x = cvt_pk_bf16(v0[0], v0[1]); w.y = cvt_pk_bf16(v0[2], v0[3]); w.z = cvt_pk_bf16(v1[0], v1[1]); w.w = cvt_pk_bf16(v1[2], v1[3]);
                    *(u32x4*)(rowp + bj * HALF) = w; } }
    }
};
struct EpiSwiglu {
    static constexpr bool PERM = true;
    bf16_t* O;
    __device__ __forceinline__ void operator()(const f32x4 (&acc)[2][2][4][2], const Unit& u, int wr, int wc, int fr, int fq) const {
        const int row0 = u.pm * BM + wr * 64 + fr, col0 = u.pn * HALF + wc * 32 + 8 * fq;
#pragma unroll
        for (int ai = 0; ai < 2; ++ai)
#pragma unroll
            for (int m = 0; m < 4; ++m) { bf16_t* rowp = O + (size_t)(row0 + ai * HALF + m * 16) * DFF + col0;
                f32x4 v0, v1;
#pragma unroll
                for (int j = 0; j < 4; ++j) { const float g0 = acc[ai][0][m][0][j], g1 = acc[ai][0][m][1][j];
                    v0[j] = g0 * fast_sigmoid(g0) * acc[ai][1][m][0][j]; v1[j] = g1 * fast_sigmoid(g1) * acc[ai][1][m][1][j]; }
                u32x4 w; w.x = cvt_pk_bf16(v0[0], v0[1]); w.y = cvt_pk_bf16(v0[2], v0[3]); w.z = cvt_pk_bf16(v1[0], v1[1]); w.w = cvt_pk_bf16(v1[2], v1[3]);
                __builtin_nontemporal_store(w, (u32x4*)rowp); }
    }
};

template <class Epi, class Sched, bool ALIGN_EPI = true>
__device__ __forceinline__ void gemm_phase(LAS unsigned char* lds, const Gemm g, const Sched& S, const Epi& E) {
    const int tid = threadIdx.x, wid = __builtin_amdgcn_readfirstlane(tid >> 6), lane = tid & 63, wr = wid >> 2, wc = wid & 3, fr = lane & 15, fq = lane >> 4;
    const int K = g.K, nt = K / BK;
    unsigned voffA[2], voffB[2];
#pragma unroll
    for (int i = 0; i < 2; ++i) { int R, C; stage_rc(tid * 16 + i * 8192, R, C); const int Rb = Epi::PERM ? ((R & ~31) + perm32(R & 31)) : R;
        voffA[i] = (unsigned)(R * g.lda + C) * 2u; voffB[i] = (unsigned)(Rb * g.ldb + C) * 2u; }
    const size_t kstep = (size_t)(BK * 2);
    const size_t hstepA = (size_t)HALF * g.lda * 2, hstepB = (size_t)HALF * g.ldb * 2;
    const size_t tstepA = 2 * hstepA, tstepB = 2 * hstepB;
    const unsigned ldsw = (unsigned)wid * 1024u;
    const int aoff = lds_byte(wr * 64 + fr, fq * 8), boff = lds_byte(wc * 32 + fr, fq * 8);
#define PG8_SA(b, h) (((b) * 2 + (h)) * HTB)
#define PG8_SB(b, h) ((4 + (b) * 2 + (h)) * HTB)
#define PG8_STAGE(bufoff, gbase, voff) do { _Pragma("unroll") for (int _i = 0; _i < 2; ++_i) \
        __builtin_amdgcn_global_load_lds((const unsigned*)((const char*)(gbase) + (voff)[_i]), (LAS unsigned*)(lds + (bufoff) + ldsw + _i * 8192), 16, 0, 0); } while (0)
#define PG8_LDA(dst, b, h) do { _Pragma("unroll") for (int m = 0; m < 4; ++m) _Pragma("unroll") for (int k = 0; k < 2; ++k) dst[m][k] = *(const LAS bf16x8*)(lds + PG8_SA(b, h) + aoff + m * 2048 + k * 1024); } while (0)
#define PG8_LDB(dst, b, h) do { _Pragma("unroll") for (int n = 0; n < 2; ++n) _Pragma("unroll") for (int k = 0; k < 2; ++k) dst[n][k] = *(const LAS bf16x8*)(lds + PG8_SB(b, h) + boff + n * 2048 + k * 1024); } while (0)
#define PG8_MMA(ai, bj, At, Bt) do { __builtin_amdgcn_s_setprio(1); _Pragma("unroll") for (int m = 0; m < 4; ++m) _Pragma("unroll") for (int n = 0; n < 2; ++n) _Pragma("unroll") for (int k = 0; k < 2; ++k) \
        acc[ai][bj][m][n] = __builtin_amdgcn_mfma_f32_16x16x32_bf16(Bt[n][k], At[m][k], acc[ai][bj][m][n], 0, 0, 0); __builtin_amdgcn_s_setprio(0); } while (0)
#define PG8_WAIT_V(n) asm volatile("s_waitcnt vmcnt(" #n ")" ::: "memory")
#define PG8_WAIT_L(n) asm volatile("s_waitcnt lgkmcnt(" #n ")" ::: "memory")
#define PG8_BAR __builtin_amdgcn_s_barrier()
#define PG8_SCHED __builtin_amdgcn_sched_barrier(0)
    Unit cur, nxt; int ui = 0;
    if (!S.next(0, cur)) return;
    f32x4 acc[2][2][4][2];
#pragma unroll
    for (int a = 0; a < 2; ++a)
#pragma unroll
        for (int b = 0; b < 2; ++b)
#pragma unroll
            for (int m = 0; m < 4; ++m)
#pragma unroll
                for (int n = 0; n < 2; ++n) acc[a][b][m][n] = (f32x4){0.f, 0.f, 0.f, 0.f};
    bf16x8 At[4][2], B0[2][2], B1[2][2];
    const char* cA = (const char*)g.A + (size_t)cur.pm * tstepA + (size_t)cur.pn * g.a_pn_off; const char* cB = (const char*)g.Bt + (size_t)cur.pn * tstepB;
    PG8_STAGE(PG8_SB(0, 0), cB, voffB); PG8_STAGE(PG8_SB(0, 1), cB + hstepB, voffB); PG8_STAGE(PG8_SA(0, 0), cA, voffA); PG8_STAGE(PG8_SA(0, 1), cA + hstepA, voffA);
    if (wr == 1) PG8_BAR;
    PG8_WAIT_V(2); PG8_BAR;
    PG8_STAGE(PG8_SB(1, 0), cB + kstep, voffB); PG8_STAGE(PG8_SA(1, 0), cA + kstep, voffA); PG8_STAGE(PG8_SB(1, 1), cB + hstepB + kstep, voffB);
    PG8_WAIT_V(6); PG8_BAR;
    for (;;) {
        const bool has_next = S.next(ui + 1, nxt);
        const char* nA = has_next ? (const char*)g.A + (size_t)nxt.pm * tstepA + (size_t)nxt.pn * g.a_pn_off : cA; const char* nB = has_next ? (const char*)g.Bt + (size_t)nxt.pn * tstepB : cB;
        for (int t = 0; t < nt; t += 2) {
            const bool last = (t == nt - 2);
            const char* a1 = cA + (size_t)(t + 1) * kstep;
            const char* a2 = last ? nA : cA + (size_t)(t + 2) * kstep; const char* b2 = last ? nB : cB + (size_t)(t + 2) * kstep;
            const char* a3 = a2 + kstep; const char* b3 = b2 + kstep;
            PG8_LDB(B0, 0, 0); PG8_LDB(B1, 0, 1); PG8_SCHED; PG8_LDA(At, 0, 0); PG8_STAGE(PG8_SA(1, 1), a1 + hstepA, voffA);
            PG8_WAIT_V(8); PG8_WAIT_L(0); PG8_BAR; PG8_MMA(0, 0, At, B0); PG8_MMA(0, 1, At, B1); PG8_BAR; PG8_SCHED;
            PG8_LDA(At, 0, 1); PG8_STAGE(PG8_SB(0, 0), b2, voffB); PG8_STAGE(PG8_SB(0, 1), b2 + hstepB, voffB); PG8_STAGE(PG8_SA(0, 0), a2, voffA);
            PG8_WAIT_V(8); PG8_WAIT_L(0); PG8_BAR; PG8_MMA(1, 0, At, B0); PG8_MMA(1, 1, At, B1); PG8_BAR; PG8_SCHED;
            PG8_LDB(B0, 1, 0); PG8_LDB(B1, 1, 1); PG8_SCHED; PG8_LDA(At, 1, 0); PG8_STAGE(PG8_SA(0, 1), a2 + hstepA, voffA);
            PG8_WAIT_V(8); PG8_WAIT_L(0); PG8_BAR; PG8_MMA(0, 0, At, B0); PG8_MMA(0, 1, At, B1); PG8_BAR; PG8_SCHED;
            PG8_LDA(At, 1, 1); PG8_STAGE(PG8_SB(1, 0), b3, voffB); PG8_STAGE(PG8_SB(1, 1), b3 + hstepB, voffB); PG8_STAGE(PG8_SA(1, 0), a3, voffA);
            PG8_WAIT_V(8); PG8_WAIT_L(0); PG8_BAR; PG8_MMA(1, 0, At, B0); PG8_MMA(1, 1, At, B1); PG8_BAR; PG8_SCHED;
        }
        if constexpr (ALIGN_EPI) { if (wr == 0) PG8_BAR; }
        E(acc, cur, wr, wc, fr, fq);
        if (!has_next) break;
#pragma unroll
        for (int a = 0; a < 2; ++a)
#pragma unroll
            for (int b = 0; b < 2; ++b)
#pragma unroll
                for (int m = 0; m < 4; ++m)
#pragma unroll
                    for (int n = 0; n < 2; ++n) acc[a][b][m][n] = (f32x4){0.f, 0.f, 0.f, 0.f};
        cur = nxt; cA = nA; cB = nB; ++ui;
        if constexpr (ALIGN_EPI) { if (wr == 1) PG8_BAR; }
    }
    PG8_WAIT_V(0);
    if constexpr (!ALIGN_EPI) { if (wr == 0) PG8_BAR; }
    PG8_BAR;
#undef PG8_SA
#undef PG8_SB
#undef PG8_STAGE
#undef PG8_LDA
#undef PG8_LDB
#undef PG8_MMA
#undef PG8_WAIT_V
#undef PG8_WAIT_L
#undef PG8_BAR
#undef PG8_SCHED
}
}

__device__ __forceinline__ void mod_task(const Params& p, LAS float* lds, int jg) {
    const int tid = threadIdx.x;
    LAS float* sc = lds;
    LAS float* red = lds + 4096;
    for (int i = tid; i < NB * Dm; i += NTHREADS) { const float v = p.c[i]; sc[i] = v * fast_sigmoid(v); }
    __syncthreads();
    const int c4 = tid & 31, ks = tid >> 5;
    const float* wp = p.w_ada + (size_t)(ks * 128) * NMOD + jg * 128 + c4 * 4;
    f32x4 a0 = (f32x4){0.f, 0.f, 0.f, 0.f}, a1 = a0;
#pragma unroll 16
    for (int kk = 0; kk < 128; ++kk) {
        const f32x4 w = __builtin_nontemporal_load((const f32x4*)(wp + (size_t)kk * NMOD));
        const float s0 = sc[ks * 128 + kk], s1 = sc[Dm + ks * 128 + kk];
        a0 += s0 * w; a1 += s1 * w;
    }
    *(LAS f32x4*)(red + (ks * 2 + 0) * 128 + c4 * 4) = a0;
    *(LAS f32x4*)(red + (ks * 2 + 1) * 128 + c4 * 4) = a1;
    __syncthreads();
    if (tid < 256) { const int b = tid >> 7, j = tid & 127; float s = p.b_ada[jg * 128 + j];
#pragma unroll
        for (int k2 = 0; k2 < 16; ++k2) s += red[(k2 * 2 + b) * 128 + j];
        p.mod[(size_t)b * NMOD + jg * 128 + j] = s; }
    __syncthreads();
}
__device__ __forceinline__ void transpose_item(const float* src, int N, bf16_t* dst, int ldd, int mode, const float* scale, int item, LAS float* scr, int lane) {
    const int nblk = N >> 5, kb = item / nblk, nb = item - kb * nblk, k0 = kb * 64, n0 = nb * 32;
    const float* s0 = src + (size_t)(k0 + (lane >> 3)) * N + n0 + (lane & 7) * 4;
    f32x4 v[8];
#pragma unroll
    for (int i = 0; i < 8; ++i) v[i] = __builtin_nontemporal_load((const f32x4*)(s0 + (size_t)(8 * i) * N));
    asm volatile("" ::: "memory"); __builtin_amdgcn_wave_barrier();
#pragma unroll
    for (int i = 0; i < 8; ++i) { LAS float* d = scr + (8 * i + (lane >> 3)) * 33 + (lane & 7) * 4; d[0] = v[i][0]; d[1] = v[i][1]; d[2] = v[i][2]; d[3] = v[i][3]; }
    asm volatile("" ::: "memory"); __builtin_amdgcn_wave_barrier();
    const int c = lane & 7;
#pragma unroll
    for (int j = 0; j < 4; ++j) { const int n = (lane >> 3) + 8 * j, nn = n0 + n; const LAS float* s = scr + (8 * c) * 33 + n;
        const float sc = scale ? scale[nn] : 1.0f;
        u32x4 o; o.x = cvt_pk_bf16(s[0] * sc, s[33] * sc); o.y = cvt_pk_bf16(s[2 * 33] * sc, s[3 * 33] * sc); o.z = cvt_pk_bf16(s[4 * 33] * sc, s[5 * 33] * sc); o.w = cvt_pk_bf16(s[6 * 33] * sc, s[7 * 33] * sc);
        const int drow = mode == 0 ? nn : (256 * (nn >> 7) + (nn & 127) + (mode == 2 ? 128 : 0));
        *(u32x4*)(dst + (size_t)drow * ldd + k0 + 8 * c) = o; }
    asm volatile("" ::: "memory"); __builtin_amdgcn_wave_barrier();
}
__device__ __forceinline__ void phase0(const Params& p, LAS float* lds) {
    const int G = gridDim.x, lane = threadIdx.x & 63, wave = threadIdx.x >> 6;
    constexpr int T_MOD = NMOD / 128;
    for (int task = blockIdx.x; task < T_MOD; task += G) mod_task(p, lds, task);
    constexpr int I_IN = (Dm / 64) * (NPROJ / 32), I_OUT = (Dm / 64) * (Dm / 32), I_G = (Dm / 64) * (DFF / 32), I_D = (DFF / 64) * (Dm / 32), I_P = 4 * 4 * 8;
    constexpr int NITEMS = I_IN + I_OUT + 2 * I_G + I_D + I_P, SKIP = 6;
    const int nmodb = G < T_MOD ? G : T_MOD, NW_NON = (G - nmodb) * NWAVES, NGW = G * NWAVES;
    const bool is_mod = (int)blockIdx.x < nmodb;
    const int vw = is_mod ? NW_NON + blockIdx.x * NWAVES + wave : (blockIdx.x - nmodb) * NWAVES + wave;
    const int skip = NW_NON > 0 ? SKIP : 0;
    LAS float* scr = lds + wave * (64 * 33);
    for (int r = 0;; ++r) {
        int it;
        if (r < skip) { if (is_mod) continue; it = r * NW_NON + vw; } else it = skip * NW_NON + (r - skip) * NGW + vw;
        if (it >= NITEMS) break;
        if (it < I_IN) { transpose_item(p.w_in, NPROJ, p.WinT, Dm, 0, nullptr, it, scr, lane); continue; } it -= I_IN;
        if (it < I_OUT) { transpose_item(p.w_out, Dm, p.WoutT, Dm, 0, nullptr, it, scr, lane); continue; } it -= I_OUT;
        if (it < I_G) { transpose_item(p.w_gate, DFF, p.WguT, Dm, 1, nullptr, it, scr, lane); continue; } it -= I_G;
        if (it < I_G) { transpose_item(p.w_up, DFF, p.WguT, Dm, 2, nullptr, it, scr, lane); continue; } it -= I_G;
        if (it < I_D) { transpose_item(p.w_down, Dm, p.WdT, DFF, 0, nullptr, it, scr, lane); continue; } it -= I_D;
        { const int gidx = it >> 5; transpose_item(p.w_pool + (size_t)gidx * 65536, 256, p.WpT + (size_t)gidx * 65536, 256, 0, p.ls_pool + gidx * 256, it & 31, scr, lane); }
    }
    for (int e = blockIdx.x * NTHREADS + threadIdx.x; e < 2 * 16 * 4096; e += G * NTHREADS) {
        const int el = e & 7, ln = (e >> 3) & 63, ks = (e >> 9) & 1, mt = (e >> 10) & 3, h = (e >> 12) & 15, gate = e >> 16;
        const int in = ks * 32 + (ln >> 4) * 8 + el, out = mt * 16 + (ln & 15);
        const float* w = gate ? p.w_rg_i : p.w_rg_a;
        p.WAf[e] = (bf16_t)(cvt_pk_bf16(w[(size_t)(h * 64 + in) * 64 + out], 0.f) & 0xffffu);
    }
}

template <int MODE>
__device__ __forceinline__ void phase_norm(const float* xin, bf16_t* d1, const bf16_t* d2, const float* g, const float* sh, const float* sc, bf16_t* hb, float* outf) {
    constexpr bool FINAL = (MODE == 2);
    const int lane = threadIdx.x & 63, wave = threadIdx.x >> 6;
    const int gw = blockIdx.x * NWAVES + wave, NGW = gridDim.x * NWAVES, rpw = (T + NGW - 1) / NGW;
    const int r0 = gw * rpw, r1 = (r0 + rpw < T) ? r0 + rpw : T;
    f32x4 fv[8], sv[8];
    int curb = -1;
    struct RowBuf { f32x4 v[8]; u32x2 a[8]; u32x2 c[8]; };
    auto load_row = [&](RowBuf& rb, const int row) __attribute__((always_inline)) {
        if (row < r1) {
#pragma unroll
            for (int j = 0; j < 8; ++j) { const size_t o = (size_t)row * Dm + j * 256 + lane * 4;
                if (MODE <= 1) rb.v[j] = __builtin_nontemporal_load((const f32x4*)(xin + o));
                if (MODE == 1) rb.a[j] = *(const u32x2*)(d1 + o);
                if (MODE == 2) { rb.a[j] = __builtin_nontemporal_load((const u32x2*)(d1 + o)); rb.c[j] = __builtin_nontemporal_load((const u32x2*)(d2 + o)); } }
        }
    };
    auto do_row = [&](RowBuf& rb, const int row) __attribute__((always_inline)) {
        if (row >= r1) return;
        const int b = row >> 14;
        if (b != curb) { curb = b;
#pragma unroll
            for (int j = 0; j < 8; ++j) { const int k = j * 256 + lane * 4; const f32x4 gg = *(const f32x4*)(g + k);
                if (!FINAL) { const f32x4 s = *(const f32x4*)(sc + (size_t)b * NMOD + k); fv[j] = gg * (1.0f + s); sv[j] = *(const f32x4*)(sh + (size_t)b * NMOD + k); }
                else { fv[j] = gg; sv[j] = (f32x4){0.f, 0.f, 0.f, 0.f}; } } }
        float ss = 0.f;
#pragma unroll
        for (int j = 0; j < 8; ++j) {
            if (MODE == 1) { const u32x2 w = rb.a[j]; rb.v[j] += (f32x4){bf_lo(w.x), bf_hi(w.x), bf_lo(w.y), bf_hi(w.y)};
                u32x2 xw; xw.x = cvt_pk_bf16(rb.v[j][0], rb.v[j][1]); xw.y = cvt_pk_bf16(rb.v[j][2], rb.v[j][3]);
                *(u32x2*)(d1 + (size_t)row * Dm + j * 256 + lane * 4) = xw; }
            if (MODE == 2) { const u32x2 w = rb.a[j], w2 = rb.c[j];
                rb.v[j] = (f32x4){bf_lo(w.x), bf_hi(w.x), bf_lo(w.y), bf_hi(w.y)} + (f32x4){bf_lo(w2.x), bf_hi(w2.x), bf_lo(w2.y), bf_hi(w2.y)}; }
            const f32x4 t = rb.v[j] * rb.v[j]; ss += (t[0] + t[1]) + (t[2] + t[3]);
        }
        ss = wave_sum(ss);
        const float rstd = 1.0f / sqrtf(ss * (1.0f / Dm) + EPS);
#pragma unroll
        for (int j = 0; j < 8; ++j) {
            const f32x4 o = rb.v[j] * rstd * fv[j] + sv[j];
            const size_t off = (size_t)row * Dm + j * 256 + lane * 4;
            if (!FINAL) { u32x2 w; w.x = cvt_pk_bf16(o[0], o[1]); w.y = cvt_pk_bf16(o[2], o[3]); *(u32x2*)(hb + off) = w; }
            else __builtin_nontemporal_store(o, (f32x4*)(outf + off));
        }
    };
    RowBuf A, B;
    load_row(A, r0);
#pragma unroll 1
    for (int row = r0; row < r1; row += 2) {
        load_row(B, row + 1); do_row(A, row);
        load_row(A, row + 2); do_row(B, row + 1);
    }
}

template <int CTRL> __device__ __forceinline__ float dppf(float oldv, float v) {
    return __builtin_bit_cast(float, __builtin_amdgcn_update_dpp(__builtin_bit_cast(int, oldv), __builtin_bit_cast(int, v), CTRL, 0xf, 0xf, false));
}
__device__ __forceinline__ void scan16x4(f32x4& a, f32x4& u) {
    float a0 = a[0], a1 = a[1], a2 = a[2], a3 = a[3], u0 = u[0], u1 = u[1], u2 = u[2], u3 = u[3];
#define SCAN_STEP(D) \
    "v_fmac_f32_dpp %4, %4, %0 row_shr:" #D " row_mask:0xf bank_mask:0xf\n" \
    "v_fmac_f32_dpp %5, %5, %1 row_shr:" #D " row_mask:0xf bank_mask:0xf\n" \
    "v_fmac_f32_dpp %6, %6, %2 row_shr:" #D " row_mask:0xf bank_mask:0xf\n" \
    "v_fmac_f32_dpp %7, %7, %3 row_shr:" #D " row_mask:0xf bank_mask:0xf\n" \
    "v_mul_f32_dpp %0, %0, %0 row_shr:" #D " row_mask:0xf bank_mask:0xf\n" \
    "v_mul_f32_dpp %1, %1, %1 row_shr:" #D " row_mask:0xf bank_mask:0xf\n" \
    "v_mul_f32_dpp %2, %2, %2 row_shr:" #D " row_mask:0xf bank_mask:0xf\n" \
    "v_mul_f32_dpp %3, %3, %3 row_shr:" #D " row_mask:0xf bank_mask:0xf\n"
    asm volatile("s_nop 4\n" SCAN_STEP(1) SCAN_STEP(2) SCAN_STEP(4) SCAN_STEP(8) "s_nop 1\n"
                 : "+v"(a0), "+v"(a1), "+v"(a2), "+v"(a3), "+v"(u0), "+v"(u1), "+v"(u2), "+v"(u3));
#undef SCAN_STEP
    a = (f32x4){a0, a1, a2, a3}; u = (f32x4){u0, u1, u2, u3};
}
constexpr int LMT = 2;
template <int VAR = 0>
__device__ __forceinline__ void lru_item(const Params& p, LAS float* tile  , int item) {
    const int lane = threadIdx.x & 63, fr = lane & 15, fq = lane >> 4;
    const int c = item & (NCH - 1), mg0 = ((item >> 6) & 1) * LMT, h = (item >> 7) & 15, b = item >> 11;
    const size_t rowbase = (size_t)b * SEQ;
    const int cch = h * 64 + 4 * fr;
    const f32x4 cw0 = *(const f32x4*)(p.w_conv + 0 * DLRU + cch), cw1 = *(const f32x4*)(p.w_conv + 1 * DLRU + cch), cw2 = *(const f32x4*)(p.w_conv + 2 * DLRU + cch), cw3 = *(const f32x4*)(p.w_conv + 3 * DLRU + cch);
    const f32x4 cbv = *(const f32x4*)(p.b_conv + cch);
    f32x4 ba[LMT], bi[LMT], cl[LMT];
    bf16x8 wa[LMT][2], wi[LMT][2];
#pragma unroll
    for (int mt = 0; mt < LMT; ++mt) { const int ch = h * 64 + (mg0 + mt) * 16 + fq * 4;
        ba[mt] = *(const f32x4*)(p.b_rg_a + ch); bi[mt] = *(const f32x4*)(p.b_rg_i + ch);
        const f32x4 lm = *(const f32x4*)(p.lam + ch);
#pragma unroll
        for (int j = 0; j < 4; ++j) { const float xl = lm[j]; cl[mt][j] = (8.0f * LOG2E) * (fminf(xl, 0.f) - log1pf(expf(-fabsf(xl)))); }
#pragma unroll
        for (int ks = 0; ks < 2; ++ks) {
            wa[mt][ks] = *(const bf16x8*)(p.WAf + ((size_t)(((0 * 16 + h) * 4 + mg0 + mt) * 2 + ks) * 64 + lane) * 8);
            wi[mt][ks] = *(const bf16x8*)(p.WAf + ((size_t)(((1 * 16 + h) * 4 + mg0 + mt) * 2 + ks) * 64 + lane) * 8); } }
    f32x4 st0[LMT], st1[LMT];
#pragma unroll
    for (int mt = 0; mt < LMT; ++mt) { st0[mt] = (f32x4){0.f, 0.f, 0.f, 0.f}; st1[mt] = (f32x4){1.f, 1.f, 1.f, 1.f}; }
    u32x2 raw[7]; u32x2 graw[LMT]; unsigned chk = 0;
    const bf16_t* xsrc = p.proj + (rowbase + (size_t)c * TC) * NPROJ + cch;
    const bf16_t* gsrc = p.proj + (rowbase + (size_t)c * TC + fr) * NPROJ + DLRU + h * 64 + mg0 * 16 + fq * 4;
#pragma unroll
    for (int i = 0; i < 7; ++i) { const int dt = 4 * fq - 3 + i;
        if (c * TC + dt >= 0) raw[i] = *(const u32x2*)(xsrc + (long)dt * NPROJ); else raw[i] = (u32x2){0u, 0u}; }
#pragma unroll
    for (int mt = 0; mt < LMT; ++mt) graw[mt] = *(const u32x2*)(gsrc + mt * 16);
    u32x2 rawB[7]; u32x2 grawB[LMT];
#pragma unroll
    for (int i = 0; i < 7; ++i) rawB[i] = *(const u32x2*)(xsrc + (size_t)16 * NPROJ + (long)(4 * fq - 3 + i) * NPROJ);
#pragma unroll
    for (int mt = 0; mt < LMT; ++mt) grawB[mt] = *(const u32x2*)(gsrc + (size_t)16 * NPROJ + mt * 16);
    auto tile_step = [&](const int nt, u32x2 (&raw)[7], u32x2 (&graw)[LMT]) __attribute__((always_inline)) {
        f32x4 xv[7];
#pragma unroll
        for (int i = 0; i < 7; ++i) xv[i] = (f32x4){bf_lo(raw[i].x), bf_hi(raw[i].x), bf_lo(raw[i].y), bf_hi(raw[i].y)};
        f32x4 gg[LMT];
#pragma unroll
        for (int mt = 0; mt < LMT; ++mt) gg[mt] = (f32x4){bf_lo(graw[mt].x), bf_hi(graw[mt].x), bf_lo(graw[mt].y), bf_hi(graw[mt].y)};
        if (!(VAR & 2) && nt + 2 < TC / 16) {
            const bf16_t* xn = xsrc + (size_t)(nt + 2) * 16 * NPROJ;
#pragma unroll
            for (int i = 0; i < 7; ++i) raw[i] = *(const u32x2*)(xn + (long)(4 * fq - 3 + i) * NPROJ);
#pragma unroll
            for (int mt = 0; mt < LMT; ++mt) graw[mt] = *(const u32x2*)(gsrc + (size_t)(nt + 2) * 16 * NPROJ + mt * 16);
        }
        asm volatile("" ::: "memory"); __builtin_amdgcn_wave_barrier();
#pragma unroll
        for (int j = 0; j < 4; ++j) { const f32x4 xc = cbv + cw0 * xv[j] + cw1 * xv[j + 1] + cw2 * xv[j + 2] + cw3 * xv[j + 3];
            *(LAS f32x4*)(tile + (4 * fq + j) * 68 + 4 * fr) = xc; }
        asm volatile("" ::: "memory"); __builtin_amdgcn_wave_barrier();
        bf16x8 bfr[2]; f32x4 xd[LMT];
#pragma unroll
        for (int ks = 0; ks < 2; ++ks) { const f32x4 lo = *(const LAS f32x4*)(tile + fr * 68 + ks * 32 + fq * 8), hi = *(const LAS f32x4*)(tile + fr * 68 + ks * 32 + fq * 8 + 4);
            u32x4 w; w.x = cvt_pk_bf16(lo[0], lo[1]); w.y = cvt_pk_bf16(lo[2], lo[3]); w.z = cvt_pk_bf16(hi[0], hi[1]); w.w = cvt_pk_bf16(hi[2], hi[3]);
            bfr[ks] = __builtin_bit_cast(bf16x8, w); }
#pragma unroll
        for (int mt = 0; mt < LMT; ++mt) xd[mt] = *(const LAS f32x4*)(tile + fr * 68 + (mg0 + mt) * 16 + fq * 4);
        asm volatile("" ::: "memory"); __builtin_amdgcn_wave_barrier();
        const size_t trow = rowbase + (size_t)c * TC + nt * 16 + fr;
#pragma unroll
        for (int mt = 0; mt < LMT; ++mt) {
            f32x4 dr = (f32x4){0.f, 0.f, 0.f, 0.f}, di = dr;
            dr = __builtin_amdgcn_mfma_f32_16x16x32_bf16(wa[mt][0], bfr[0], dr, 0, 0, 0); dr = __builtin_amdgcn_mfma_f32_16x16x32_bf16(wa[mt][1], bfr[1], dr, 0, 0, 0);
            di = __builtin_amdgcn_mfma_f32_16x16x32_bf16(wi[mt][0], bfr[0], di, 0, 0, 0); di = __builtin_amdgcn_mfma_f32_16x16x32_bf16(wi[mt][1], bfr[1], di, 0, 0, 0);
            f32x4 av, uv;
#pragma unroll
            for (int j = 0; j < 4; ++j) {
                const float r = fast_sigmoid(dr[j] + ba[mt][j]), ig = fast_sigmoid(di[j] + bi[mt][j]);
                const float a = __builtin_amdgcn_exp2f(r * cl[mt][j]);
                av[j] = a; uv[j] = __builtin_amdgcn_sqrtf(1.0f - a * a) * ig * xd[mt][j];
            }
            scan16x4(av, uv);
            const int ch = h * 64 + (mg0 + mt) * 16 + fq * 4;
            f32x4 y, z;
#pragma unroll
            for (int j = 0; j < 4; ++j) { const float hh = fmaf(av[j], st0[mt][j], uv[j]), zz = av[j] * st1[mt][j];
                st0[mt][j] = __shfl(hh, lane | 15); st1[mt][j] = __shfl(zz, lane | 15);
                const float gx = gg[mt][j]; const float ge = gx * fast_sigmoid(1.5957691216057308f * (gx + 0.044715f * gx * gx * gx));
                y[j] = hh * ge; z[j] = zz * ge; }
            u32x2 w; w.x = cvt_pk_bf16(y[0], y[1]); w.y = cvt_pk_bf16(y[2], y[3]);
            u32x2 w2; w2.x = cvt_pk_bf16(z[0], z[1]); w2.y = cvt_pk_bf16(z[2], z[3]);
            if (!(VAR & 1)) { *(u32x4*)(p.zbuf + trow * (2 * DLRU) + 2 * ch) = (u32x4){w.x, w.y, w2.x, w2.y}; }
            else chk += (w.x ^ w.y) + (w2.x ^ w2.y);
        }
    };
#pragma unroll 1
    for (int nt = 0; nt < TC / 16; nt += 2) { tile_step(nt, raw, graw); tile_step(nt + 1, rawB, grawB); }
    if (VAR) { if (chk == 0x12345u && st0[0][0] == 3.25f) p.aggE[0] = 1.0f; return; }
    if (fr == 15) {
#pragma unroll
        for (int mt = 0; mt < LMT; ++mt) { const size_t o = ((size_t)(b * NCH + c)) * DLRU + h * 64 + (mg0 + mt) * 16 + fq * 4;
            *(f32x4*)(p.aggE + o) = st0[mt]; *(f32x4*)(p.aggP + o) = st1[mt]; }
    }
}
__device__ __forceinline__ void lru_fixup(const Params& p, int item) {
    const int lane = threadIdx.x & 63, q = lane & 15;
    const int c = item & (NCH - 1), h = (item >> 6) & 15, b = item >> 10;
    float hin = 0.f;
    { const float* pP = p.aggP + (size_t)(b * NCH) * DLRU + h * 64 + lane; const float* pE = p.aggE + (size_t)(b * NCH) * DLRU + h * 64 + lane;
#pragma unroll 8
      for (int cc = 0; cc < c; ++cc) hin = pP[(size_t)cc * DLRU] * hin + pE[(size_t)cc * DLRU]; }
    float cy[4];
#pragma unroll
    for (int e = 0; e < 4; ++e) cy[e] = __shfl(hin, q * 4 + e);
    const size_t row0 = (size_t)b * SEQ + (size_t)c * TC + (lane >> 4);
    bf16_t* yp = p.ycat + row0 * Dm + h * 64 + q * 4;
    const bf16_t* zp = p.zbuf + row0 * (2 * DLRU) + (h * 64 + q * 4) * 2;
#pragma unroll 8
    for (int i = 0; i < TC / 4; ++i) {
        const u32x4 w = __builtin_nontemporal_load((const u32x4*)(zp + (size_t)(4 * i) * (2 * DLRU)));
        u32x2 o;
        o.x = cvt_pk_bf16(fmaf(bf_lo(w.z), cy[0], bf_lo(w.x)), fmaf(bf_hi(w.z), cy[1], bf_hi(w.x)));
        o.y = cvt_pk_bf16(fmaf(bf_lo(w.w), cy[2], bf_lo(w.y)), fmaf(bf_hi(w.w), cy[3], bf_hi(w.y)));
        *(u32x2*)(yp + (size_t)(4 * i) * Dm) = o;
    }
}
template <int W>
__device__ __forceinline__ void pool_block(const Params& p, int b, int gidx, int t0) {
    const int lane = threadIdx.x & 63;
    const bf16_t* src = p.proj + ((size_t)b * SEQ) * NPROJ + 2 * DLRU + gidx * 256 + lane * 4;
    bf16_t* dst = p.pooled + ((size_t)b * SEQ) * DLRU + gidx * 256 + lane * 4;
    u32x2 pre[W - 1], rw[2][16];
#pragma unroll
    for (int k = 0; k < W - 1; ++k) { const int tk = t0 - W + 1 + k; pre[k] = (u32x2){0u, 0u}; if (tk >= 0) pre[k] = __builtin_nontemporal_load((const u32x2*)(src + (size_t)tk * NPROJ)); }
#pragma unroll
    for (int ii = 0; ii < 16; ++ii) rw[0][ii] = __builtin_nontemporal_load((const u32x2*)(src + (size_t)(t0 + ii) * NPROJ));
    f32x4 ring[W]; f32x4 S = (f32x4){0.f, 0.f, 0.f, 0.f};
#pragma unroll
    for (int k = 0; k < W - 1; ++k) { const f32x4 v = (f32x4){bf_lo(pre[k].x), bf_hi(pre[k].x), bf_lo(pre[k].y), bf_hi(pre[k].y)}; ring[k] = v; S += v; }
    ring[W - 1] = (f32x4){0.f, 0.f, 0.f, 0.f};
#pragma unroll
    for (int grp = 0; grp < 4; ++grp) {
        if (grp + 1 < 4) {
#pragma unroll
            for (int ii = 0; ii < 16; ++ii) rw[(grp + 1) & 1][ii] = __builtin_nontemporal_load((const u32x2*)(src + (size_t)(t0 + (grp + 1) * 16 + ii) * NPROJ));
        }
#pragma unroll
        for (int ii = 0; ii < 16; ++ii) { const int t = t0 + grp * 16 + ii; const u32x2 r = rw[grp & 1][ii];
            const f32x4 x = (f32x4){bf_lo(r.x), bf_hi(r.x), bf_lo(r.y), bf_hi(r.y)};
            S += x;
            const float inv = (t + 1 < W) ? __builtin_amdgcn_rcpf((float)(t + 1)) : 1.0f / (float)W;
            const f32x4 o = S * inv - x;
            u32x2 w; w.x = cvt_pk_bf16(o[0], o[1]); w.y = cvt_pk_bf16(o[2], o[3]);
            *(u32x2*)(dst + (size_t)t * DLRU) = w;
            S -= ring[ii % W]; ring[(ii + W - 1) % W] = x; }
    }
}
__device__ __forceinline__ void pool_items(const Params& p) {
    const int wave = threadIdx.x >> 6;
    const int gw = blockIdx.x * NWAVES + wave, NGW = gridDim.x * NWAVES;
    for (int item = gw; item < NB * 4 * (SEQ / 64); item += NGW) {
        const int gidx = item & 3, blk = (item >> 2) & (SEQ / 64 - 1), b = item >> 10;
        if (gidx == 0) pool_block<2>(p, b, 0, blk * 64);
        else if (gidx == 1) pool_block<4>(p, b, 1, blk * 64);
        else if (gidx == 2) pool_block<8>(p, b, 2, blk * 64);
        else pool_block<16>(p, b, 3, blk * 64);
    }
}

#define XB_TMO      128
#define XB_XCNT(j)  (256  + 64 * (j))
#define XB_XSUB(j)  (1280 + 64 * (j))
#define XB_XGEN(j)  (2304 + 64 * (j))
#define XB_TOP      3328
#define XB_TOPGEN   3392
#define XCD_BAR_WORDS 3456
#define XB_SPIN_CAP (1u << 18)
__device__ __forceinline__ unsigned xb_ld(unsigned* p)              { return __hip_atomic_load(p, __ATOMIC_RELAXED, __HIP_MEMORY_SCOPE_AGENT); }
__device__ __forceinline__ unsigned xb_add(unsigned* p, unsigned v) { return __hip_atomic_fetch_add(p, v, __ATOMIC_RELAXED, __HIP_MEMORY_SCOPE_AGENT); }
__device__ __forceinline__ unsigned xb_xcc_id() { return (unsigned)__builtin_amdgcn_s_getreg((3 << 11) | 20) & 0xFu; }
#define XB_SPIN(cond, bar) do { unsigned _sp = 0; while (cond) { __builtin_amdgcn_s_sleep(1); \
    if ((++_sp & 255u) == 0u) { if (xb_ld(&(bar)[XB_TMO])) break; if (_sp > XB_SPIN_CAP) { atomicAdd(&(bar)[XB_TMO], 1u); break; } } } } while (0)
struct XcdBarrier { unsigned* bar; unsigned x; volatile LAS unsigned* st; };
__device__ __forceinline__ XcdBarrier xcd_barrier_post(unsigned* bar, volatile LAS unsigned* st) {
    XcdBarrier b; b.bar = bar; b.x = xb_xcc_id(); b.st = st;
    if (threadIdx.x == 0) (void)xb_add(&bar[XB_XCNT(b.x)], 1u);
    return b;
}
__device__ __forceinline__ void xcd_barrier_complete(unsigned* bar, unsigned x, unsigned& nloc, unsigned& nx) {
    const unsigned G = gridDim.x * gridDim.y * gridDim.z;
    unsigned sum, cnt, mine, sp = 0u;
    for (;;) {
        sum = 0u; cnt = 0u; mine = 0u;
#pragma unroll
        for (unsigned j = 0; j < 16; ++j) { const unsigned c = xb_ld(&bar[XB_XCNT(j)]); sum += c; cnt += (c > 0u) ? 1u : 0u; mine = (j == x) ? c : mine; }
        if (sum == G) break;
        __builtin_amdgcn_s_sleep(1);
        if ((++sp & 255u) == 0u) { if (xb_ld(&bar[XB_TMO])) break; if (sp > XB_SPIN_CAP) { atomicAdd(&bar[XB_TMO], 1u); break; } }
    }
    nloc = mine > 0u ? mine : 1u; nx = cnt > 0u ? cnt : 1u;
}
__device__ __forceinline__ void xcd_barrier(const XcdBarrier& b) {
    asm volatile("s_waitcnt vmcnt(0)" ::: "memory");
    __syncthreads();
    if (threadIdx.x == 0) {
        unsigned* bar = b.bar;
        __builtin_amdgcn_s_waitcnt(0);
        unsigned nloc = b.st[0], nx = b.st[1];
        if (nloc == 0u) { xcd_barrier_complete(bar, b.x, nloc, nx); b.st[0] = nloc; b.st[1] = nx; }
        const unsigned old = xb_add(&bar[XB_XSUB(b.x)], 1u);
        const unsigned gen = old / nloc;
        if (old + 1u == (gen + 1u) * nloc) {
            __builtin_amdgcn_fence(__ATOMIC_RELEASE, "agent");
            asm volatile("s_waitcnt vmcnt(0)" ::: "memory");
            const unsigned og = xb_add(&bar[XB_TOP], 1u);
            const unsigned tg = og / nx;
            if (og + 1u == (tg + 1u) * nx) xb_add(&bar[XB_TOPGEN], 1u);
            else XB_SPIN(xb_ld(&bar[XB_TOPGEN]) == tg, bar);
            __builtin_amdgcn_fence(__ATOMIC_ACQUIRE, "agent");
            xb_add(&bar[XB_XGEN(b.x)], 1u);
            asm volatile("s_waitcnt vmcnt(0)" ::: "memory");
        } else {
            XB_SPIN(xb_ld(&bar[XB_XGEN(b.x)]) == gen, bar);
            __builtin_amdgcn_fence(__ATOMIC_ACQUIRE, "agent");
            asm volatile("s_waitcnt vmcnt(0)" ::: "memory");
        }
    }
    __syncthreads();
}

constexpr int NPHASE = 10;
#ifndef PHMASK
#define PHMASK 0x3ff
#endif
#define PH_ON(k) (((PHMASK) >> (k)) & 1)
#define SYNC_BEFORE(k) if (ph_lo < (k) && (k) < ph_hi) xcd_barrier(xb);
#ifndef PROBE_SUB
#define PROBE_SUB 0
#endif
#ifndef DUPMASK
#define DUPMASK 0
#endif
#define NREP(k) ((((DUPMASK) >> (k)) & 1) ? 2 : 1)
template <int K>
__device__ __forceinline__ void run_phase(const Params& p, LAS unsigned char* lds) {
    const int G = gridDim.x, wave = threadIdx.x >> 6;
    if constexpr (K == 0) { phase0(p, (LAS float*)lds); }
    if constexpr (K == 1) { phase_norm<0>(p.x, nullptr, nullptr, p.g_mix, p.mod + 0 * Dm, p.mod + 1 * Dm, p.HB, nullptr); }
    if constexpr (K == 2) { pg8::Gemm g{p.HB, p.WinT, T, NPROJ, Dm, Dm, Dm, 0}; pg8::StaticOrder S; S.init(T, NPROJ, G, blockIdx.x); pg8::EpiBf16 E{p.proj, NPROJ};
        pg8::gemm_phase<pg8::EpiBf16, pg8::StaticOrder>(lds, g, S, E); }
    if constexpr (K == 3) {
#pragma unroll 1
        for (int s = 0; s < 2; ++s) {
            if (((s ^ (wave >> 2)) & 1) == 0) { for (int item = blockIdx.x * NWAVES + wave; item < NB * 16 * (4 / LMT) * NCH; item += G * NWAVES) lru_item(p, (LAS float*)lds + wave * (16 * 68), item); }
            else pool_items(p);
        } }
    if constexpr (K == 4) {
        for (int item = blockIdx.x * NWAVES + wave; item < NB * 16 * NCH; item += G * NWAVES) lru_fixup(p, item);
        pg8::Gemm g{p.pooled, p.WpT, T, DLRU, 256, DLRU, 256, 512}; pg8::StaticOrder S; S.init(T, DLRU, G, blockIdx.x); pg8::EpiBf16 E{p.ycat + DLRU, Dm};
        pg8::gemm_phase<pg8::EpiBf16, pg8::StaticOrder>(lds, g, S, E); }
    if constexpr (K == 5) { pg8::Gemm g{p.ycat, p.WoutT, T, Dm, Dm, Dm, Dm, 0}; pg8::StaticOrder S; S.init(T, Dm, G, blockIdx.x); pg8::EpiGateBf16 E{p.d1, p.mod + 2 * Dm};
        pg8::gemm_phase<pg8::EpiGateBf16, pg8::StaticOrder>(lds, g, S, E); }
    if constexpr (K == 6) { phase_norm<1>(p.x, p.d1, nullptr, p.g_ffn, p.mod + 3 * Dm, p.mod + 4 * Dm, p.HB, nullptr); }
    if constexpr (K == 7) { pg8::Gemm g{p.HB, p.WguT, T, NGU, Dm, Dm, Dm, 0}; pg8::StaticOrder S; S.init(T, NGU, G, blockIdx.x); pg8::EpiSwiglu E{p.act};
        pg8::gemm_phase<pg8::EpiSwiglu, pg8::StaticOrder>(lds, g, S, E); }
    if constexpr (K == 8) { pg8::Gemm g{p.act, p.WdT, T, Dm, DFF, DFF, DFF, 0}; pg8::StaticOrder S; S.init(T, Dm, G, blockIdx.x); pg8::EpiGateBf16 E{p.d2, p.mod + 5 * Dm};
        pg8::gemm_phase<pg8::EpiGateBf16, pg8::StaticOrder>(lds, g, S, E); }
    if constexpr (K == 9) { phase_norm<2>(nullptr, p.d1, p.d2, p.g_final, nullptr, nullptr, nullptr, p.out); }
}
#define DO_PHASE(k) SYNC_BEFORE(k) if (PH_ON(k) && ph_lo <= (k) && (k) < ph_hi) { run_phase<k>(p, lds); if (NREP(k) > 1) { xcd_barrier(xb); run_phase<k>(p, lds); } }
__global__ void __launch_bounds__(NTHREADS, 2) fwd_megakernel(Params p, int ph_lo, int ph_hi) {
    extern __shared__ __attribute__((aligned(16))) unsigned char shm[];
    LAS unsigned char* lds = (LAS unsigned char*)shm;
    cg::grid_group grid = cg::this_grid();
    __shared__ uint4 xb_words;
    if (threadIdx.x == 0) xb_words = make_uint4(0u, 0u, 0u, 0u);
    __syncthreads();
    const XcdBarrier xb = xcd_barrier_post(p.bar, (volatile LAS unsigned*)&xb_words);
    if (ph_lo == 0x7fffffff) grid.sync();
    DO_PHASE(0) DO_PHASE(1) DO_PHASE(2) DO_PHASE(3) DO_PHASE(4) DO_PHASE(5) DO_PHASE(6) DO_PHASE(7) DO_PHASE(8) DO_PHASE(9)
}

extern "C" void kernel_launch(void* const* d_in, const int* in_sizes, int n_in, void* d_out, int out_size, void* d_ws, size_t ws_size, hipStream_t stream) {
    constexpr size_t LDS_BYTES = pg8::STAGE_BYTES;
    static int grid_blocks = 0;
    if (!grid_blocks) {
        int dev = 0, cus = 0, per_cu = 0;
        hipGetDevice(&dev);
        hipDeviceGetAttribute(&cus, hipDeviceAttributeMultiprocessorCount, dev);
        hipFuncSetAttribute((const void*)fwd_megakernel, hipFuncAttributeMaxDynamicSharedMemorySize, (int)LDS_BYTES);
        hipOccupancyMaxActiveBlocksPerMultiprocessor(&per_cu, (const void*)fwd_megakernel, NTHREADS, LDS_BYTES);
        per_cu = 1;
        if (cus < 1) cus = 256;
        grid_blocks = cus * per_cu;
    }
    Params p{};
    const float* const* in = (const float* const*)d_in;
    p.x = in[0]; p.c = in[1]; p.w_ada = in[2]; p.b_ada = in[3]; p.g_mix = in[4]; p.w_in = in[5]; p.w_conv = in[6]; p.b_conv = in[7];
    p.w_rg_a = in[8]; p.b_rg_a = in[9]; p.w_rg_i = in[10]; p.b_rg_i = in[11]; p.lam = in[12]; p.w_pool = in[13]; p.ls_pool = in[14];
    p.w_out = in[15]; p.g_ffn = in[16]; p.w_gate = in[17]; p.w_up = in[18]; p.w_down = in[19]; p.g_final = in[20];
    p.out = (float*)d_out;
    unsigned char* ws = (unsigned char*)d_ws; size_t off = 0;
    auto take = [&](size_t bytes) { unsigned char* r = ws + off; off += (bytes + 255) & ~(size_t)255; return r; };
    p.bar = (unsigned*)take((size_t)XCD_BAR_WORDS * 4);
    p.WinT = (bf16_t*)take((size_t)NPROJ * Dm * 2);
    p.WoutT = (bf16_t*)take((size_t)Dm * Dm * 2);
    p.WguT = (bf16_t*)take((size_t)NGU * Dm * 2);
    p.WdT = (bf16_t*)take((size_t)Dm * DFF * 2);
    p.WpT = (bf16_t*)take((size_t)DLRU * 256 * 2);
    p.WAf = (bf16_t*)take((size_t)2 * 16 * 4096 * 2);
    p.mod = (float*)take((size_t)NB * NMOD * 4);
    p.aggP = (float*)take((size_t)NB * NCH * DLRU * 4);
    p.aggE = (float*)take((size_t)NB * NCH * DLRU * 4);
    p.HB = (bf16_t*)take((size_t)T * Dm * 2);
    p.d1 = (bf16_t*)take((size_t)T * Dm * 2);
    p.d2 = (bf16_t*)take((size_t)T * Dm * 2);
    unsigned char* r1 = take(0);
    p.proj = (bf16_t*)take((size_t)T * NPROJ * 2);
    p.pooled = (bf16_t*)take((size_t)T * DLRU * 2);
    p.ycat = (bf16_t*)take((size_t)T * Dm * 2);
    p.act = (bf16_t*)r1;
    p.zbuf = p.HB;
    (void)hipMemsetAsync(p.bar, 0, (size_t)XCD_BAR_WORDS * 4, stream);
    int ph_lo = 0, ph_hi = NPHASE;
    void* args[] = {&p, &ph_lo, &ph_hi};
    hipError_t e = hipLaunchCooperativeKernel((const void*)fwd_megakernel, dim3(grid_blocks), dim3(NTHREADS), args, (unsigned)LDS_BYTES, stream);
    if (e != hipSuccess) fprintf(stderr, "cooperative launch failed: %s (grid %d)\n", hipGetErrorString(e), grid_blocks);
}
```

```cpp
#include <hip/hip_runtime.h>
#include <hip/hip_cooperative_groups.h>
#include <cstdio>
#include <cstdint>
namespace cg = cooperative_groups;

#define LAS __attribute__((address_space(3)))
typedef unsigned short bf16_t;
typedef short bf16x8 __attribute__((ext_vector_type(8)));
typedef float f32x4 __attribute__((ext_vector_type(4)));
typedef unsigned u32x4 __attribute__((ext_vector_type(4)));
typedef unsigned u32x2 __attribute__((ext_vector_type(2)));

constexpr int Dm = 2048, NB = 2, SEQ = 16384, T = NB * SEQ, DLRU = 1024, NPROJ = 3072, DFF = 5632, NGU = 2 * DFF, NMOD = 6 * Dm;
constexpr int TC = 256, NCH = SEQ / TC;
constexpr int NTHREADS = 512, NWAVES = 8;
constexpr float EPS = 1e-6f;
constexpr float LOG2E = 1.4426950408889634f;

struct Params {
    const float *x, *c, *w_ada, *b_ada, *g_mix, *w_in, *w_conv, *b_conv, *w_rg_a, *b_rg_a, *w_rg_i, *b_rg_i, *lam, *w_pool, *ls_pool, *w_out, *g_ffn, *w_gate, *w_up, *w_down, *g_final;
    float* out;
    bf16_t *WinT, *WoutT, *WguT, *WdT, *WpT, *WAf;
    float *mod, *aggP, *aggE;
    bf16_t *HB, *proj, *pooled, *ycat, *act, *zbuf;
    bf16_t *d1, *d2;
    unsigned* bar;
};

__device__ __forceinline__ unsigned cvt_pk_bf16(float lo, float hi) { unsigned r; asm("v_cvt_pk_bf16_f32 %0, %1, %2" : "=v"(r) : "v"(lo), "v"(hi)); return r; }
__device__ __forceinline__ float bf_lo(unsigned w) { return __uint_as_float(w << 16); }
__device__ __forceinline__ float bf_hi(unsigned w) { return __uint_as_float(w & 0xffff0000u); }
__device__ __forceinline__ float fast_sigmoid(float v) { return __builtin_amdgcn_rcpf(1.0f + __builtin_amdgcn_exp2f(-LOG2E * v)); }
__device__ __forceinline__ float wave_sum(float v) {
#pragma unroll
    for (int o = 1; o < 64; o <<= 1) v += __shfl_xor(v, o);
    return v;
}

namespace pg8 {
constexpr int BM = 256, BK = 64, HALF = 128, HTB = HALF * BK * 2  , STAGE_BYTES = 8 * HTB, NXCD = 8, WGM = 8;

__host__ __device__ __forceinline__ int lds_byte(int r, int c) { const int st = (r >> 4) * 2 + (c >> 5), rr = r & 15, cc = c & 31, ob = rr * 64 + cc * 2; return st * 1024 + (ob ^ (((ob >> 9) & 1) << 5)); }
__host__ __device__ __forceinline__ void stage_rc(int b, int& R, int& C) { const int st = b / 1024, sb = b % 1024, swz = sb ^ (((sb >> 9) & 1) << 5); R = (st >> 1) * 16 + swz / 64; C = (st & 1) * 32 + (swz % 64) / 2; }
__host__ __device__ __forceinline__ int perm32(int rho) { const int n = rho >> 4, i = rho & 15; return 8 * (i >> 2) + 4 * n + (i & 3); }

struct Unit { int pm, pn; };
struct Gemm { const bf16_t* A; const bf16_t* Bt; int M, N, K, lda, ldb, a_pn_off; };

struct StaticOrder {
    int nM, nN, nwg, G, c;
    __host__ __device__ void init(int M, int N, int G_, int c_) { nM = M / BM; nN = N / BM; nwg = nM * nN; G = G_; c = c_; }
    __host__ __device__ bool next(int i, Unit& u) const {
        const long L = (long)i * G + c; if (L >= nwg) return false;
        int wgid = (int)L; { const int q = nwg / NXCD, r = nwg % NXCD, xcd = wgid % NXCD, off = wgid / NXCD; wgid = (xcd < r ? xcd * (q + 1) : r * (q + 1) + (xcd - r) * q) + off; }
        const int nig = WGM * nN, gid = wgid / nig, fm = gid * WGM, gsz = (nM - fm) < WGM ? (nM - fm) : WGM;
        u.pm = fm + ((wgid % nig) % gsz); u.pn = (wgid % nig) / gsz; return true;
    }
};

struct EpiBf16 {
    static constexpr bool PERM = true;
    bf16_t* O; int ldc;
    __device__ __forceinline__ void operator()(const f32x4 (&acc)[2][2][4][2], const Unit& u, int wr, int wc, int fr, int fq) const {
        const int row0 = u.pm * BM + wr * 64 + fr, col0 = u.pn * BM + wc * 32 + 8 * fq;
#pragma unroll
        for (int ai = 0; ai < 2; ++ai)
#pragma unroll
            for (int m = 0; m < 4; ++m) { bf16_t* rowp = O + (size_t)(row0 + ai * HALF + m * 16) * ldc + col0;
#pragma unroll
                for (int bj = 0; bj < 2; ++bj) { const f32x4 v0 = acc[ai][bj][m][0], v1 = acc[ai][bj][m][1];
                    u32x4 w; w.x = cvt_pk_bf16(v0[0], v0[1]); w.y = cvt_pk_bf16(v0[2], v0[3]); w.z = cvt_pk_bf16(v1[0], v1[1]); w.w = cvt_pk_bf16(v1[2], v1[3]);
                    *(u32x4*)(rowp + bj * HALF) = w; } }
    }
};
struct EpiGateBf16 {
    static constexpr bool PERM = true;
    bf16_t* O; const float* gate;
    __device__ __forceinline__ void operator()(const f32x4 (&acc)[2][2][4][2], const Unit& u, int wr, int wc, int fr, int fq) const {
        const int row0 = u.pm * BM + wr * 64 + fr, col0 = u.pn * BM + wc * 32 + 8 * fq;
        const float* gp = gate + (size_t)(u.pm >> 6) * NMOD + col0;
        f32x4 gv[2][2];
#pragma unroll
        for (int bj = 0; bj < 2; ++bj)
#pragma unroll
            for (int n = 0; n < 2; ++n) gv[bj][n] = *(const f32x4*)(gp + bj * HALF + n * 4);
#pragma unroll
        for (int ai = 0; ai < 2; ++ai)
#pragma unroll
            for (int m = 0; m < 4; ++m) { bf16_t* rowp = O + (size_t)(row0 + ai * HALF + m * 16) * Dm + col0;
#pragma unroll
                for (int bj = 0; bj < 2; ++bj) { const f32x4 v0 = acc[ai][bj][m][0] * gv[bj][0], v1 = acc[ai][bj][m][1] * gv[bj][1];
                    u32x4 w; w.x = cvt_pk_bf16(v0[0], v0[1]); w.y = cvt_pk_bf16(v0[2], v0[3]); w.z = cvt_pk_bf16(v1[0], v1[1]); w.w = cvt_pk_bf16(v1[2], v1[3]);
                    *(u32x4*)(rowp + bj * HALF) = w; } }
    }
};
struct EpiSwiglu {
    static constexpr bool PERM = true;
    bf16_t* O;
    __device__ __forceinline__ void operator()(const f32x4 (&acc)[2][2][4][2], const Unit& u, int wr, int wc, int fr, int fq) const {
        const int row0 = u.pm * BM + wr * 64 + fr, col0 = u.pn * HALF + wc * 32 + 8 * fq;
#pragma unroll
        for (int ai = 0; ai < 2; ++ai)
#pragma unroll
            for (int m = 0; m < 4; ++m) { bf16_t* rowp = O + (size_t)(row0 + ai * HALF + m * 16) * DFF + col0;
                f32x4 v0, v1;
#pragma unroll
                for (int j = 0; j < 4; ++j) { const float g0 = acc[ai][0][m][0][j], g1 = acc[ai][0][m][1][j];
                    v0[j] = g0 * fast_sigmoid(g0) * acc[ai][1][m][0][j]; v1[j] = g1 * fast_sigmoid(g1) * acc[ai][1][m][1][j]; }
                u32x4 w; w.x = cvt_pk_bf16(v0[0], v0[1]); w.y = cvt_pk_bf16(v0[2], v0[3]); w.z = cvt_pk_bf16(v1[0], v1[1]); w.w = cvt_pk_bf16(v1[2], v1[3]);
                __builtin_nontemporal_store(w, (u32x4*)rowp); }
    }
};

template <class Epi, class Sched, bool ALIGN_EPI = true>
__device__ __forceinline__ void gemm_phase(LAS unsigned char* lds, const Gemm g, const Sched& S, const Epi& E) {
    const int tid = threadIdx.x, wid = __builtin_amdgcn_readfirstlane(tid >> 6), lane = tid & 63, wr = wid >> 2, wc = wid & 3, fr = lane & 15, fq = lane >> 4;
    const int K = g.K, nt = K / BK;
    unsigned voffA[2], voffB[2];
#pragma unroll
    for (int i = 0; i < 2; ++i) { int R, C; stage_rc(tid * 16 + i * 8192, R, C); const int Rb = Epi::PERM ? ((R & ~31) + perm32(R & 31)) : R;
        voffA[i] = (unsigned)(R * g.lda + C) * 2u; voffB[i] = (unsigned)(Rb * g.ldb + C) * 2u; }
    const size_t kstep = (size_t)(BK * 2);
    const size_t hstepA = (size_t)HALF * g.lda * 2, hstepB = (size_t)HALF * g.ldb * 2;
    const size_t tstepA = 2 * hstepA, tstepB = 2 * hstepB;
    const unsigned ldsw = (unsigned)wid * 1024u;
    const int aoff = lds_byte(wr * 64 + fr, fq * 8), boff = lds_byte(wc * 32 + fr, fq * 8);
#define PG8_SA(b, h) (((b) * 2 + (h)) * HTB)
#define PG8_SB(b, h) ((4 + (b) * 2 + (h)) * HTB)
#define PG8_STAGE(bufoff, gbase, voff) do { _Pragma("unroll") for (int _i = 0; _i < 2; ++_i) \
        __builtin_amdgcn_global_load_lds((const unsigned*)((const char*)(gbase) + (voff)[_i]), (LAS unsigned*)(lds + (bufoff) + ldsw + _i * 8192), 16, 0, 0); } while (0)
#define PG8_LDA(dst, b, h) do { _Pragma("unroll") for (int m = 0; m < 4; ++m) _Pragma("unroll") for (int k = 0; k < 2; ++k) dst[m][k] = *(const LAS bf16x8*)(lds + PG8_SA(b, h) + aoff + m * 2048 + k * 1024); } while (0)
#define PG8_LDB(dst, b, h) do { _Pragma("unroll") for (int n = 0; n < 2; ++n) _Pragma("unroll") for (int k = 0; k < 2; ++k) dst[n][k] = *(const LAS bf16x8*)(lds + PG8_SB(b, h) + boff + n * 2048 + k * 1024); } while (0)
#define PG8_MMA(ai, bj, At, Bt) do { __builtin_amdgcn_s_setprio(1); _Pragma("unroll") for (int m = 0; m < 4; ++m) _Pragma("unroll") for (int n = 0; n < 2; ++n) _Pragma("unroll") for (int k = 0; k < 2; ++k) \
        acc[ai][bj][m][n] = __builtin_amdgcn_mfma_f32_16x16x32_bf16(Bt[n][k], At[m][k], acc[ai][bj][m][n], 0, 0, 0); __builtin_amdgcn_s_setprio(0); } while (0)
#define PG8_WAIT_V(n) asm volatile("s_waitcnt vmcnt(" #n ")" ::: "memory")
#define PG8_WAIT_L(n) asm volatile("s_waitcnt lgkmcnt(" #n ")" ::: "memory")
#define PG8_BAR __builtin_amdgcn_s_barrier()
#define PG8_SCHED __builtin_amdgcn_sched_barrier(0)
    Unit cur, nxt; int ui = 0;
    if (!S.next(0, cur)) return;
    f32x4 acc[2][2][4][2];
#pragma unroll
    for (int a = 0; a < 2; ++a)
#pragma unroll
        for (int b = 0; b < 2; ++b)
#pragma unroll
            for (int m = 0; m < 4; ++m)
#pragma unroll
                for (int n = 0; n < 2; ++n) acc[a][b][m][n] = (f32x4){0.f, 0.f, 0.f, 0.f};
    bf16x8 At[4][2], B0[2][2], B1[2][2];
    const char* cA = (const char*)g.A + (size_t)cur.pm * tstepA + (size_t)cur.pn * g.a_pn_off; const char* cB = (const char*)g.Bt + (size_t)cur.pn * tstepB;
    PG8_STAGE(PG8_SB(0, 0), cB, voffB); PG8_STAGE(PG8_SB(0, 1), cB + hstepB, voffB); PG8_STAGE(PG8_SA(0, 0), cA, voffA); PG8_STAGE(PG8_SA(0, 1), cA + hstepA, voffA);
    if (wr == 1) PG8_BAR;
    PG8_WAIT_V(2); PG8_BAR;
    PG8_STAGE(PG8_SB(1, 0), cB + kstep, voffB); PG8_STAGE(PG8_SA(1, 0), cA + kstep, voffA); PG8_STAGE(PG8_SB(1, 1), cB + hstepB + kstep, voffB);
    PG8_WAIT_V(6); PG8_BAR;
    for (;;) {
        const bool has_next = S.next(ui + 1, nxt);
        const char* nA = has_next ? (const char*)g.A + (size_t)nxt.pm * tstepA + (size_t)nxt.pn * g.a_pn_off : cA; const char* nB = has_next ? (const char*)g.Bt + (size_t)nxt.pn * tstepB : cB;
        for (int t = 0; t < nt; t += 2) {
            const bool last = (t == nt - 2);
            const char* a1 = cA + (size_t)(t + 1) * kstep;
            const char* a2 = last ? nA : cA + (size_t)(t + 2) * kstep; const char* b2 = last ? nB : cB + (size_t)(t + 2) * kstep;
            const char* a3 = a2 + kstep; const char* b3 = b2 + kstep;
            PG8_LDB(B0, 0, 0); PG8_LDB(B1, 0, 1); PG8_SCHED; PG8_LDA(At, 0, 0); PG8_STAGE(PG8_SA(1, 1), a1 + hstepA, voffA);
            PG8_WAIT_V(8); PG8_WAIT_L(0); PG8_BAR; PG8_MMA(0, 0, At, B0); PG8_MMA(0, 1, At, B1); PG8_BAR; PG8_SCHED;
            PG8_LDA(At, 0, 1); PG8_STAGE(PG8_SB(0, 0), b2, voffB); PG8_STAGE(PG8_SB(0, 1), b2 + hstepB, voffB); PG8_STAGE(PG8_SA(0, 0), a2, voffA);
            PG8_WAIT_V(8); PG8_WAIT_L(0); PG8_BAR; PG8_MMA(1, 0, At, B0); PG8_MMA(1, 1, At, B1); PG8_BAR; PG8_SCHED;
            PG8_LDB(B0, 1, 0); PG8_LDB(B1, 1, 1); PG8_SCHED; PG8_LDA(At, 1, 0); PG8_STAGE(PG8_SA(0, 1), a2 + hstepA, voffA);
            PG8_WAIT_V(8); PG8_WAIT_L(0); PG8_BAR; PG8_MMA(0, 0, At, B0); PG8_MMA(0, 1, At, B1); PG8_BAR; PG8_SCHED;
            PG8_LDA(At, 1, 1); PG8_STAGE(PG8_SB(1, 0), b3, voffB); PG8_STAGE(PG8_SB(1, 1), b3 + hstepB, voffB); PG8_STAGE(PG8_SA(1, 0), a3, voffA);
            PG8_WAIT_V(8); PG8_WAIT_L(0); PG8_BAR; PG8_MMA(1, 0, At, B0); PG8_MMA(1, 1, At, B1); PG8_BAR; PG8_SCHED;
        }
        if constexpr (ALIGN_EPI) { if (wr == 0) PG8_BAR; }
        E(acc, cur, wr, wc, fr, fq);
        if (!has_next) break;
#pragma unroll
        for (int a = 0; a < 2; ++a)
#pragma unroll
            for (int b = 0; b < 2; ++b)
#pragma unroll
                for (int m = 0; m < 4; ++m)
#pragma unroll
                    for (int n = 0; n < 2; ++n) acc[a][b][m][n] = (f32x4){0.f, 0.f, 0.f, 0.f};
        cur = nxt; cA = nA; cB = nB; ++ui;
        if constexpr (ALIGN_EPI) { if (wr == 1) PG8_BAR; }
    }
    PG8_WAIT_V(0);
    if constexpr (!ALIGN_EPI) { if (wr == 0) PG8_BAR; }
    PG8_BAR;
#undef PG8_SA
#undef PG8_SB
#undef PG8_STAGE
#undef PG8_LDA
#undef PG8_LDB
#undef PG8_MMA
#undef PG8_WAIT_V
#undef PG8_WAIT_L
#undef PG8_BAR
#undef PG8_SCHED
}
}

__device__ __forceinline__ void mod_task(const Params& p, LAS float* lds, int jg) {
    const int tid = threadIdx.x;
    LAS float* sc = lds;
    LAS float* red = lds + 4096;
    for (int i = tid; i < NB * Dm; i += NTHREADS) { const float v = p.c[i]; sc[i] = v * fast_sigmoid(v); }
    __syncthreads();
    const int c4 = tid & 31, ks = tid >> 5;
    const float* wp = p.w_ada + (size_t)(ks * 128) * NMOD + jg * 128 + c4 * 4;
    f32x4 a0 = (f32x4){0.f, 0.f, 0.f, 0.f}, a1 = a0;
#pragma unroll 16
    for (int kk = 0; kk < 128; ++kk) {
        const f32x4 w = __builtin_nontemporal_load((const f32x4*)(wp + (size_t)kk * NMOD));
        const float s0 = sc[ks * 128 + kk], s1 = sc[Dm + ks * 128 + kk];
        a0 += s0 * w; a1 += s1 * w;
    }
    *(LAS f32x4*)(red + (ks * 2 + 0) * 128 + c4 * 4) = a0;
    *(LAS f32x4*)(red + (ks * 2 + 1) * 128 + c4 * 4) = a1;
    __syncthreads();
    if (tid < 256) { const int b = tid >> 7, j = tid & 127; float s = p.b_ada[jg * 128 + j];
#pragma unroll
        for (int k2 = 0; k2 < 16; ++k2) s += red[(k2 * 2 + b) * 128 + j];
        p.mod[(size_t)b * NMOD + jg * 128 + j] = s; }
    __syncthreads();
}
__device__ __forceinline__ void transpose_item(const float* src, int N, bf16_t* dst, int ldd, int mode, const float* scale, int item, LAS float* scr, int lane) {
    const int nblk = N >> 5, kb = item / nblk, nb = item - kb * nblk, k0 = kb * 64, n0 = nb * 32;
    const float* s0 = src + (size_t)(k0 + (lane >> 3)) * N + n0 + (lane & 7) * 4;
    f32x4 v[8];
#pragma unroll
    for (int i = 0; i < 8; ++i) v[i] = __builtin_nontemporal_load((const f32x4*)(s0 + (size_t)(8 * i) * N));
    asm volatile("" ::: "memory"); __builtin_amdgcn_wave_barrier();
#pragma unroll
    for (int i = 0; i < 8; ++i) { LAS float* d = scr + (8 * i + (lane >> 3)) * 33 + (lane & 7) * 4; d[0] = v[i][0]; d[1] = v[i][1]; d[2] = v[i][2]; d[3] = v[i][3]; }
    asm volatile("" ::: "memory"); __builtin_amdgcn_wave_barrier();
    const int c = lane & 7;
#pragma unroll
    for (int j = 0; j < 4; ++j) { const int n = (lane >> 3) + 8 * j, nn = n0 + n; const LAS float* s = scr + (8 * c) * 33 + n;
        const float sc = scale ? scale[nn] : 1.0f;
        u32x4 o; o.x = cvt_pk_bf16(s[0] * sc, s[33] * sc); o.y = cvt_pk_bf16(s[2 * 33] * sc, s[3 * 33] * sc); o.z = cvt_pk_bf16(s[4 * 33] * sc, s[5 * 33] * sc); o.w = cvt_pk_bf16(s[6 * 33] * sc, s[7 * 33] * sc);
        const int drow = mode == 0 ? nn : (256 * (nn >> 7) + (nn & 127) + (mode == 2 ? 128 : 0));
        *(u32x4*)(dst + (size_t)drow * ldd + k0 + 8 * c) = o; }
    asm volatile("" ::: "memory"); __builtin_amdgcn_wave_barrier();
}
__device__ __forceinline__ void phase0(const Params& p, LAS float* lds) {
    const int G = gridDim.x, lane = threadIdx.x & 63, wave = threadIdx.x >> 6;
    constexpr int T_MOD = NMOD / 128;
    for (int task = blockIdx.x; task < T_MOD; task += G) mod_task(p, lds, task);
    constexpr int I_IN = (Dm / 64) * (NPROJ / 32), I_OUT = (Dm / 64) * (Dm / 32), I_G = (Dm / 64) * (DFF / 32), I_D = (DFF / 64) * (Dm / 32), I_P = 4 * 4 * 8;
    constexpr int NITEMS = I_IN + I_OUT + 2 * I_G + I_D + I_P, SKIP = 6;
    const int nmodb = G < T_MOD ? G : T_MOD, NW_NON = (G - nmodb) * NWAVES, NGW = G * NWAVES;
    const bool is_mod = (int)blockIdx.x < nmodb;
    const int vw = is_mod ? NW_NON + blockIdx.x * NWAVES + wave : (blockIdx.x - nmodb) * NWAVES + wave;
    const int skip = NW_NON > 0 ? SKIP : 0;
    LAS float* scr = lds + wave * (64 * 33);
    for (int r = 0;; ++r) {
        int it;
        if (r < skip) { if (is_mod) continue; it = r * NW_NON + vw; } else it = skip * NW_NON + (r - skip) * NGW + vw;
        if (it >= NITEMS) break;
        if (it < I_IN) { transpose_item(p.w_in, NPROJ, p.WinT, Dm, 0, nullptr, it, scr, lane); continue; } it -= I_IN;
        if (it < I_OUT) { transpose_item(p.w_out, Dm, p.WoutT, Dm, 0, nullptr, it, scr, lane); continue; } it -= I_OUT;
        if (it < I_G) { transpose_item(p.w_gate, DFF, p.WguT, Dm, 1, nullptr, it, scr, lane); continue; } it -= I_G;
        if (it < I_G) { transpose_item(p.w_up, DFF, p.WguT, Dm, 2, nullptr, it, scr, lane); continue; } it -= I_G;
        if (it < I_D) { transpose_item(p.w_down, Dm, p.WdT, DFF, 0, nullptr, it, scr, lane); continue; } it -= I_D;
        { const int gidx = it >> 5; transpose_item(p.w_pool + (size_t)gidx * 65536, 256, p.WpT + (size_t)gidx * 65536, 256, 0, p.ls_pool + gidx * 256, it & 31, scr, lane); }
    }
    for (int e = blockIdx.x * NTHREADS + threadIdx.x; e < 2 * 16 * 4096; e += G * NTHREADS) {
        const int el = e & 7, ln = (e >> 3) & 63, ks = (e >> 9) & 1, mt = (e >> 10) & 3, h = (e >> 12) & 15, gate = e >> 16;
        const int in = ks * 32 + (ln >> 4) * 8 + el, out = mt * 16 + (ln & 15);
        const float* w = gate ? p.w_rg_i : p.w_rg_a;
        p.WAf[e] = (bf16_t)(cvt_pk_bf16(w[(size_t)(h * 64 + in) * 64 + out], 0.f) & 0xffffu);
    }
}

template <int MODE>
__device__ __forceinline__ void phase_norm(const float* xin, bf16_t* d1, const bf16_t* d2, const float* g, const float* sh, const float* sc, bf16_t* hb, float* outf) {
    constexpr bool FINAL = (MODE == 2);
    const int lane = threadIdx.x & 63, wave = threadIdx.x >> 6;
    const int gw = blockIdx.x * NWAVES + wave, NGW = gridDim.x * NWAVES, rpw = (T + NGW - 1) / NGW;
    const int r0 = gw * rpw, r1 = (r0 + rpw < T) ? r0 + rpw : T;
    f32x4 fv[8], sv[8];
    int curb = -1;
    struct RowBuf { f32x4 v[8]; u32x2 a[8]; u32x2 c[8]; };
    auto load_row = [&](RowBuf& rb, const int row) __attribute__((always_inline)) {
        if (row < r1) {
#pragma unroll
            for (int j = 0; j < 8; ++j) { const size_t o = (size_t)row * Dm + j * 256 + lane * 4;
                if (MODE <= 1) rb.v[j] = __builtin_nontemporal_load((const f32x4*)(xin + o));
                if (MODE == 1) rb.a[j] = __builtin_nontemporal_load((const u32x2*)(d1 + o));
                if (MODE == 2) { rb.a[j] = __builtin_nontemporal_load((const u32x2*)(d1 + o)); rb.c[j] = __builtin_nontemporal_load((const u32x2*)(d2 + o)); } }
        }
    };
    auto do_row = [&](RowBuf& rb, const int row) __attribute__((always_inline)) {
        if (row >= r1) return;
        const int b = row >> 14;
        if (b != curb) { curb = b;
#pragma unroll
            for (int j = 0; j < 8; ++j) { const int k = j * 256 + lane * 4; const f32x4 gg = *(const f32x4*)(g + k);
                if (!FINAL) { const f32x4 s = *(const f32x4*)(sc + (size_t)b * NMOD + k); fv[j] = gg * (1.0f + s); sv[j] = *(const f32x4*)(sh + (size_t)b * NMOD + k); }
                else { fv[j] = gg; sv[j] = (f32x4){0.f, 0.f, 0.f, 0.f}; } } }
        float ss = 0.f;
#pragma unroll
        for (int j = 0; j < 8; ++j) {
            if (MODE == 1) { const u32x2 w = rb.a[j]; rb.v[j] += (f32x4){bf_lo(w.x), bf_hi(w.x), bf_lo(w.y), bf_hi(w.y)};
                u32x2 xw; xw.x = cvt_pk_bf16(rb.v[j][0], rb.v[j][1]); xw.y = cvt_pk_bf16(rb.v[j][2], rb.v[j][3]);
                __builtin_nontemporal_store(xw, (u32x2*)(d1 + (size_t)row * Dm + j * 256 + lane * 4)); }
            if (MODE == 2) { const u32x2 w = rb.a[j], w2 = rb.c[j];
                rb.v[j] = (f32x4){bf_lo(w.x), bf_hi(w.x), bf_lo(w.y), bf_hi(w.y)} + (f32x4){bf_lo(w2.x), bf_hi(w2.x), bf_lo(w2.y), bf_hi(w2.y)}; }
            const f32x4 t = rb.v[j] * rb.v[j]; ss += (t[0] + t[1]) + (t[2] + t[3]);
        }
        ss = wave_sum(ss);
        const float rstd = 1.0f / sqrtf(ss * (1.0f / Dm) + EPS);
#pragma unroll
        for (int j = 0; j < 8; ++j) {
            const f32x4 o = rb.v[j] * rstd * fv[j] + sv[j];
            const size_t off = (size_t)row * Dm + j * 256 + lane * 4;
            if (!FINAL) { u32x2 w; w.x = cvt_pk_bf16(o[0], o[1]); w.y = cvt_pk_bf16(o[2], o[3]); *(u32x2*)(hb + off) = w; }
            else __builtin_nontemporal_store(o, (f32x4*)(outf + off));
        }
    };
    RowBuf A, B;
    load_row(A, r0);
#pragma unroll 1
    for (int row = r0; row < r1; row += 2) {
        load_row(B, row + 1); do_row(A, row);
        load_row(A, row + 2); do_row(B, row + 1);
    }
}

template <int CTRL> __device__ __forceinline__ float dppf(float oldv, float v) {
    return __builtin_bit_cast(float, __builtin_amdgcn_update_dpp(__builtin_bit_cast(int, oldv), __builtin_bit_cast(int, v), CTRL, 0xf, 0xf, false));
}
__device__ __forceinline__ void scan16x4(f32x4& a, f32x4& u) {
    float a0 = a[0], a1 = a[1], a2 = a[2], a3 = a[3], u0 = u[0], u1 = u[1], u2 = u[2], u3 = u[3];
#define SCAN_STEP(D) \
    "v_fmac_f32_dpp %4, %4, %0 row_shr:" #D " row_mask:0xf bank_mask:0xf\n" \
    "v_fmac_f32_dpp %5, %5, %1 row_shr:" #D " row_mask:0xf bank_mask:0xf\n" \
    "v_fmac_f32_dpp %6, %6, %2 row_shr:" #D " row_mask:0xf bank_mask:0xf\n" \
    "v_fmac_f32_dpp %7, %7, %3 row_shr:" #D " row_mask:0xf bank_mask:0xf\n" \
    "v_mul_f32_dpp %0, %0, %0 row_shr:" #D " row_mask:0xf bank_mask:0xf\n" \
    "v_mul_f32_dpp %1, %1, %1 row_shr:" #D " row_mask:0xf bank_mask:0xf\n" \
    "v_mul_f32_dpp %2, %2, %2 row_shr:" #D " row_mask:0xf bank_mask:0xf\n" \
    "v_mul_f32_dpp %3, %3, %3 row_shr:" #D " row_mask:0xf bank_mask:0xf\n"
    asm volatile("s_nop 4\n" SCAN_STEP(1) SCAN_STEP(2) SCAN_STEP(4) SCAN_STEP(8) "s_nop 1\n"
                 : "+v"(a0), "+v"(a1), "+v"(a2), "+v"(a3), "+v"(u0), "+v"(u1), "+v"(u2), "+v"(u3));
#undef SCAN_STEP
    a = (f32x4){a0, a1, a2, a3}; u = (f32x4){u0, u1, u2, u3};
}
constexpr int LMT = 2;
template <int VAR = 0>
__device__ __forceinline__ void lru_item(const Params& p, LAS float* tile  , int item) {
    const int lane = threadIdx.x & 63, fr = lane & 15, fq = lane >> 4;
    const int c = item & (NCH - 1), mg0 = ((item >> 6) & 1) * LMT, h = (item >> 7) & 15, b = item >> 11;
    const size_t rowbase = (size_t)b * SEQ;
    const int cch = h * 64 + 4 * fr;
    const f32x4 cw0 = *(const f32x4*)(p.w_conv + 0 * DLRU + cch), cw1 = *(const f32x4*)(p.w_conv + 1 * DLRU + cch), cw2 = *(const f32x4*)(p.w_conv + 2 * DLRU + cch), cw3 = *(const f32x4*)(p.w_conv + 3 * DLRU + cch);
    const f32x4 cbv = *(const f32x4*)(p.b_conv + cch);
    f32x4 ba[LMT], bi[LMT], cl[LMT];
    bf16x8 wa[LMT][2], wi[LMT][2];
#pragma unroll
    for (int mt = 0; mt < LMT; ++mt) { const int ch = h * 64 + (mg0 + mt) * 16 + fq * 4;
        ba[mt] = *(const f32x4*)(p.b_rg_a + ch); bi[mt] = *(const f32x4*)(p.b_rg_i + ch);
        const f32x4 lm = *(const f32x4*)(p.lam + ch);
#pragma unroll
        for (int j = 0; j < 4; ++j) { const float xl = lm[j]; cl[mt][j] = (8.0f * LOG2E) * (fminf(xl, 0.f) - log1pf(expf(-fabsf(xl)))); }
#pragma unroll
        for (int ks = 0; ks < 2; ++ks) {
            wa[mt][ks] = *(const bf16x8*)(p.WAf + ((size_t)(((0 * 16 + h) * 4 + mg0 + mt) * 2 + ks) * 64 + lane) * 8);
            wi[mt][ks] = *(const bf16x8*)(p.WAf + ((size_t)(((1 * 16 + h) * 4 + mg0 + mt) * 2 + ks) * 64 + lane) * 8); } }
    f32x4 st0[LMT], st1[LMT];
#pragma unroll
    for (int mt = 0; mt < LMT; ++mt) { st0[mt] = (f32x4){0.f, 0.f, 0.f, 0.f}; st1[mt] = (f32x4){1.f, 1.f, 1.f, 1.f}; }
    u32x2 raw[7]; u32x2 graw[LMT]; unsigned chk = 0;
    const bf16_t* xsrc = p.proj + (rowbase + (size_t)c * TC) * NPROJ + cch;
    const bf16_t* gsrc = p.proj + (rowbase + (size_t)c * TC + fr) * NPROJ + DLRU + h * 64 + mg0 * 16 + fq * 4;
#pragma unroll
    for (int i = 0; i < 7; ++i) { const int dt = 4 * fq - 3 + i;
        if (c * TC + dt >= 0) raw[i] = *(const u32x2*)(xsrc + (long)dt * NPROJ); else raw[i] = (u32x2){0u, 0u}; }
#pragma unroll
    for (int mt = 0; mt < LMT; ++mt) graw[mt] = *(const u32x2*)(gsrc + mt * 16);
    u32x2 rawB[7]; u32x2 grawB[LMT];
#pragma unroll
    for (int i = 0; i < 7; ++i) rawB[i] = *(const u32x2*)(xsrc + (size_t)16 * NPROJ + (long)(4 * fq - 3 + i) * NPROJ);
#pragma unroll
    for (int mt = 0; mt < LMT; ++mt) grawB[mt] = *(const u32x2*)(gsrc + (size_t)16 * NPROJ + mt * 16);
    auto tile_step = [&](const int nt, u32x2 (&raw)[7], u32x2 (&graw)[LMT]) __attribute__((always_inline)) {
        f32x4 xv[7];
#pragma unroll
        for (int i = 0; i < 7; ++i) xv[i] = (f32x4){bf_lo(raw[i].x), bf_hi(raw[i].x), bf_lo(raw[i].y), bf_hi(raw[i].y)};
        f32x4 gg[LMT];
#pragma unroll
        for (int mt = 0; mt < LMT; ++mt) gg[mt] = (f32x4){bf_lo(graw[mt].x), bf_hi(graw[mt].x), bf_lo(graw[mt].y), bf_hi(graw[mt].y)};
        if (!(VAR & 2) && nt + 2 < TC / 16) {
            const bf16_t* xn = xsrc + (size_t)(nt + 2) * 16 * NPROJ;
#pragma unroll
            for (int i = 0; i < 7; ++i) raw[i] = *(const u32x2*)(xn + (long)(4 * fq - 3 + i) * NPROJ);
#pragma unroll
            for (int mt = 0; mt < LMT; ++mt) graw[mt] = *(const u32x2*)(gsrc + (size_t)(nt + 2) * 16 * NPROJ + mt * 16);
        }
        asm volatile("" ::: "memory"); __builtin_amdgcn_wave_barrier();
#pragma unroll
        for (int j = 0; j < 4; ++j) { const f32x4 xc = cbv + cw0 * xv[j] + cw1 * xv[j + 1] + cw2 * xv[j + 2] + cw3 * xv[j + 3];
            *(LAS f32x4*)(tile + (4 * fq + j) * 68 + 4 * fr) = xc; }
        asm volatile("" ::: "memory"); __builtin_amdgcn_wave_barrier();
        bf16x8 bfr[2]; f32x4 xd[LMT];
#pragma unroll
        for (int ks = 0; ks < 2; ++ks) { const f32x4 lo = *(const LAS f32x4*)(tile + fr * 68 + ks * 32 + fq * 8), hi = *(const LAS f32x4*)(tile + fr * 68 + ks * 32 + fq * 8 + 4);
            u32x4 w; w.x = cvt_pk_bf16(lo[0], lo[1]); w.y = cvt_pk_bf16(lo[2], lo[3]); w.z = cvt_pk_bf16(hi[0], hi[1]); w.w = cvt_pk_bf16(hi[2], hi[3]);
            bfr[ks] = __builtin_bit_cast(bf16x8, w); }
#pragma unroll
        for (int mt = 0; mt < LMT; ++mt) xd[mt] = *(const LAS f32x4*)(tile + fr * 68 + (mg0 + mt) * 16 + fq * 4);
        asm volatile("" ::: "memory"); __builtin_amdgcn_wave_barrier();
        const size_t trow = rowbase + (size_t)c * TC + nt * 16 + fr;
#pragma unroll
        for (int mt = 0; mt < LMT; ++mt) {
            f32x4 dr = (f32x4){0.f, 0.f, 0.f, 0.f}, di = dr;
            dr = __builtin_amdgcn_mfma_f32_16x16x32_bf16(wa[mt][0], bfr[0], dr, 0, 0, 0); dr = __builtin_amdgcn_mfma_f32_16x16x32_bf16(wa[mt][1], bfr[1], dr, 0, 0, 0);
            di = __builtin_amdgcn_mfma_f32_16x16x32_bf16(wi[mt][0], bfr[0], di, 0, 0, 0); di = __builtin_amdgcn_mfma_f32_16x16x32_bf16(wi[mt][1], bfr[1], di, 0, 0, 0);
            f32x4 av, uv;
#pragma unroll
            for (int j = 0; j < 4; ++j) {
                const float r = fast_sigmoid(dr[j] + ba[mt][j]), ig = fast_sigmoid(di[j] + bi[mt][j]);
                const float a = __builtin_amdgcn_exp2f(r * cl[mt][j]);
                av[j] = a; uv[j] = __builtin_amdgcn_sqrtf(1.0f - a * a) * ig * xd[mt][j];
            }
            scan16x4(av, uv);
            const int ch = h * 64 + (mg0 + mt) * 16 + fq * 4;
            f32x4 y, z;
#pragma unroll
            for (int j = 0; j < 4; ++j) { const float hh = fmaf(av[j], st0[mt][j], uv[j]), zz = av[j] * st1[mt][j];
                st0[mt][j] = __shfl(hh, lane | 15); st1[mt][j] = __shfl(zz, lane | 15);
                const float gx = gg[mt][j]; const float ge = gx * fast_sigmoid(1.5957691216057308f * (gx + 0.044715f * gx * gx * gx));
                y[j] = hh * ge; z[j] = zz * ge; }
            u32x2 w; w.x = cvt_pk_bf16(y[0], y[1]); w.y = cvt_pk_bf16(y[2], y[3]);
            u32x2 w2; w2.x = cvt_pk_bf16(z[0], z[1]); w2.y = cvt_pk_bf16(z[2], z[3]);
            if (!(VAR & 1)) { *(u32x4*)(p.zbuf + trow * (2 * DLRU) + 2 * ch) = (u32x4){w.x, w.y, w2.x, w2.y}; }
            else chk += (w.x ^ w.y) + (w2.x ^ w2.y);
        }
    };
#pragma unroll 1
    for (int nt = 0; nt < TC / 16; nt += 2) { tile_step(nt, raw, graw); tile_step(nt + 1, rawB, grawB); }
    if (VAR) { if (chk == 0x12345u && st0[0][0] == 3.25f) p.aggE[0] = 1.0f; return; }
    if (fr == 15) {
#pragma unroll
        for (int mt = 0; mt < LMT; ++mt) { const size_t o = ((size_t)(b * NCH + c)) * DLRU + h * 64 + (mg0 + mt) * 16 + fq * 4;
            *(f32x4*)(p.aggE + o) = st0[mt]; *(f32x4*)(p.aggP + o) = st1[mt]; }
    }
}
__device__ __forceinline__ void lru_fixup(const Params& p, int item) {
    const int lane = threadIdx.x & 63, q = lane & 15;
    const int c = item & (NCH - 1), h = (item >> 6) & 15, b = item >> 10;
    float hin = 0.f;
    { const float* pP = p.aggP + (size_t)(b * NCH) * DLRU + h * 64 + lane; const float* pE = p.aggE + (size_t)(b * NCH) * DLRU + h * 64 + lane;
#pragma unroll 8
      for (int cc = 0; cc < c; ++cc) hin = pP[(size_t)cc * DLRU] * hin + pE[(size_t)cc * DLRU]; }
    float cy[4];
#pragma unroll
    for (int e = 0; e < 4; ++e) cy[e] = __shfl(hin, q * 4 + e);
    const size_t row0 = (size_t)b * SEQ + (size_t)c * TC + (lane >> 4);
    bf16_t* yp = p.ycat + row0 * Dm + h * 64 + q * 4;
    const bf16_t* zp = p.zbuf + row0 * (2 * DLRU) + (h * 64 + q * 4) * 2;
#pragma unroll 8
    for (int i = 0; i < TC / 4; ++i) {
        const u32x4 w = __builtin_nontemporal_load((const u32x4*)(zp + (size_t)(4 * i) * (2 * DLRU)));
        u32x2 o;
        o.x = cvt_pk_bf16(fmaf(bf_lo(w.z), cy[0], bf_lo(w.x)), fmaf(bf_hi(w.z), cy[1], bf_hi(w.x)));
        o.y = cvt_pk_bf16(fmaf(bf_lo(w.w), cy[2], bf_lo(w.y)), fmaf(bf_hi(w.w), cy[3], bf_hi(w.y)));
        *(u32x2*)(yp + (size_t)(4 * i) * Dm) = o;
    }
}
template <int W>
__device__ __forceinline__ void pool_block(const Params& p, int b, int gidx, int t0) {
    const int lane = threadIdx.x & 63;
    const bf16_t* src = p.proj + ((size_t)b * SEQ) * NPROJ + 2 * DLRU + gidx * 256 + lane * 4;
    bf16_t* dst = p.pooled + ((size_t)b * SEQ) * DLRU + gidx * 256 + lane * 4;
    u32x2 pre[W - 1], rw[2][16];
#pragma unroll
    for (int k = 0; k < W - 1; ++k) { const int tk = t0 - W + 1 + k; pre[k] = (u32x2){0u, 0u}; if (tk >= 0) pre[k] = __builtin_nontemporal_load((const u32x2*)(src + (size_t)tk * NPROJ)); }
#pragma unroll
    for (int ii = 0; ii < 16; ++ii) rw[0][ii] = __builtin_nontemporal_load((const u32x2*)(src + (size_t)(t0 + ii) * NPROJ));
    f32x4 ring[W]; f32x4 S = (f32x4){0.f, 0.f, 0.f, 0.f};
#pragma unroll
    for (int k = 0; k < W - 1; ++k) { const f32x4 v = (f32x4){bf_lo(pre[k].x), bf_hi(pre[k].x), bf_lo(pre[k].y), bf_hi(pre[k].y)}; ring[k] = v; S += v; }
    ring[W - 1] = (f32x4){0.f, 0.f, 0.f, 0.f};
#pragma unroll
    for (int grp = 0; grp < 4; ++grp) {
        if (grp + 1 < 4) {
#pragma unroll
            for (int ii = 0; ii < 16; ++ii) rw[(grp + 1) & 1][ii] = __builtin_nontemporal_load((const u32x2*)(src + (size_t)(t0 + (grp + 1) * 16 + ii) * NPROJ));
        }
#pragma unroll
        for (int ii = 0; ii < 16; ++ii) { const int t = t0 + grp * 16 + ii; const u32x2 r = rw[grp & 1][ii];
            const f32x4 x = (f32x4){bf_lo(r.x), bf_hi(r.x), bf_lo(r.y), bf_hi(r.y)};
            S += x;
            const float inv = (t + 1 < W) ? __builtin_amdgcn_rcpf((float)(t + 1)) : 1.0f / (float)W;
            const f32x4 o = S * inv - x;
            u32x2 w; w.x = cvt_pk_bf16(o[0], o[1]); w.y = cvt_pk_bf16(o[2], o[3]);
            *(u32x2*)(dst + (size_t)t * DLRU) = w;
            S -= ring[ii % W]; ring[(ii + W - 1) % W] = x; }
    }
}
__device__ __forceinline__ void pool_items(const Params& p) {
    const int wave = threadIdx.x >> 6;
    const int gw = blockIdx.x * NWAVES + wave, NGW = gridDim.x * NWAVES;
    for (int item = gw; item < NB * 4 * (SEQ / 64); item += NGW) {
        const int gidx = item & 3, blk = (item >> 2) & (SEQ / 64 - 1), b = item >> 10;
        if (gidx == 0) pool_block<2>(p, b, 0, blk * 64);
        else if (gidx == 1) pool_block<4>(p, b, 1, blk * 64);
        else if (gidx == 2) pool_block<8>(p, b, 2, blk * 64);
        else pool_block<16>(p, b, 3, blk * 64);
    }
}

#define XB_TMO      128
#define XB_XCNT(j)  (256  + 64 * (j))
#define XB_XSUB(j)  (1280 + 64 * (j))
#define XB_XGEN(j)  (2304 + 64 * (j))
#define XB_TOP      3328
#define XB_TOPGEN   3392
#define XCD_BAR_WORDS 3456
#define XB_SPIN_CAP (1u << 18)
__device__ __forceinline__ unsigned xb_ld(unsigned* p)              { return __hip_atomic_load(p, __ATOMIC_RELAXED, __HIP_MEMORY_SCOPE_AGENT); }
__device__ __forceinline__ unsigned xb_add(unsigned* p, unsigned v) { return __hip_atomic_fetch_add(p, v, __ATOMIC_RELAXED, __HIP_MEMORY_SCOPE_AGENT); }
__device__ __forceinline__ unsigned xb_xcc_id() { return (unsigned)__builtin_amdgcn_s_getreg((3 << 11) | 20) & 0xFu; }
#define XB_SPIN(cond, bar) do { unsigned _sp = 0; while (cond) { __builtin_amdgcn_s_sleep(1); \
    if ((++_sp & 255u) == 0u) { if (xb_ld(&(bar)[XB_TMO])) break; if (_sp > XB_SPIN_CAP) { atomicAdd(&(bar)[XB_TMO], 1u); break; } } } } while (0)
struct XcdBarrier { unsigned* bar; unsigned x; volatile LAS unsigned* st; };
__device__ __forceinline__ XcdBarrier xcd_barrier_post(unsigned* bar, volatile LAS unsigned* st) {
    XcdBarrier b; b.bar = bar; b.x = xb_xcc_id(); b.st = st;
    if (threadIdx.x == 0) (void)xb_add(&bar[XB_XCNT(b.x)], 1u);
    return b;
}
__device__ __forceinline__ void xcd_barrier_complete(unsigned* bar, unsigned x, unsigned& nloc, unsigned& nx) {
    const unsigned G = gridDim.x * gridDim.y * gridDim.z;
    unsigned sum, cnt, mine, sp = 0u;
    for (;;) {
        sum = 0u; cnt = 0u; mine = 0u;
#pragma unroll
        for (unsigned j = 0; j < 16; ++j) { const unsigned c = xb_ld(&bar[XB_XCNT(j)]); sum += c; cnt += (c > 0u) ? 1u : 0u; mine = (j == x) ? c : mine; }
        if (sum == G) break;
        __builtin_amdgcn_s_sleep(1);
        if ((++sp & 255u) == 0u) { if (xb_ld(&bar[XB_TMO])) break; if (sp > XB_SPIN_CAP) { atomicAdd(&bar[XB_TMO], 1u); break; } }
    }
    nloc = mine > 0u ? mine : 1u; nx = cnt > 0u ? cnt : 1u;
}
__device__ __forceinline__ void xcd_barrier(const XcdBarrier& b) {
    asm volatile("s_waitcnt vmcnt(0)" ::: "memory");
    __syncthreads();
    if (threadIdx.x == 0) {
        unsigned* bar = b.bar;
        __builtin_amdgcn_s_waitcnt(0);
        unsigned nloc = b.st[0], nx = b.st[1];
        if (nloc == 0u) { xcd_barrier_complete(bar, b.x, nloc, nx); b.st[0] = nloc; b.st[1] = nx; }
        const unsigned old = xb_add(&bar[XB_XSUB(b.x)], 1u);
        const unsigned gen = old / nloc;
        if (old + 1u == (gen + 1u) * nloc) {
            __builtin_amdgcn_fence(__ATOMIC_RELEASE, "agent");
            asm volatile("s_waitcnt vmcnt(0)" ::: "memory");
            const unsigned og = xb_add(&bar[XB_TOP], 1u);
            const unsigned tg = og / nx;
            if (og + 1u == (tg + 1u) * nx) xb_add(&bar[XB_TOPGEN], 1u);
            else XB_SPIN(xb_ld(&bar[XB_TOPGEN]) == tg, bar);
            __builtin_amdgcn_fence(__ATOMIC_ACQUIRE, "agent");
            xb_add(&bar[XB_XGEN(b.x)], 1u);
            asm volatile("s_waitcnt vmcnt(0)" ::: "memory");
        } else {
            XB_SPIN(xb_ld(&bar[XB_XGEN(b.x)]) == gen, bar);
            __builtin_amdgcn_fence(__ATOMIC_ACQUIRE, "agent");
            asm volatile("s_waitcnt vmcnt(0)" ::: "memory");
        }
    }
    __syncthreads();
}

constexpr int NPHASE = 10;
#ifndef PHMASK
#define PHMASK 0x3ff
#endif
#define PH_ON(k) (((PHMASK) >> (k)) & 1)
#define SYNC_BEFORE(k) if (ph_lo < (k) && (k) < ph_hi) xcd_barrier(xb);
#ifndef PROBE_SUB
#define PROBE_SUB 0
#endif
#ifndef DUPMASK
#define DUPMASK 0
#endif
#define NREP(k) ((((DUPMASK) >> (k)) & 1) ? 2 : 1)
template <int K>
__device__ __forceinline__ void run_phase(const Params& p, LAS unsigned char* lds) {
    const int G = gridDim.x, wave = threadIdx.x >> 6;
    if constexpr (K == 0) { phase0(p, (LAS float*)lds); }
    if constexpr (K == 1) { phase_norm<0>(p.x, nullptr, nullptr, p.g_mix, p.mod + 0 * Dm, p.mod + 1 * Dm, p.HB, nullptr); }
    if constexpr (K == 2) { pg8::Gemm g{p.HB, p.WinT, T, NPROJ, Dm, Dm, Dm, 0}; pg8::StaticOrder S; S.init(T, NPROJ, G, blockIdx.x); pg8::EpiBf16 E{p.proj, NPROJ};
        pg8::gemm_phase<pg8::EpiBf16, pg8::StaticOrder>(lds, g, S, E); }
    if constexpr (K == 3) {
#pragma unroll 1
        for (int s = 0; s < 2; ++s) {
            if (((s ^ (wave >> 2)) & 1) == 0) { for (int item = blockIdx.x * NWAVES + wave; item < NB * 16 * (4 / LMT) * NCH; item += G * NWAVES) lru_item(p, (LAS float*)lds + wave * (16 * 68), item); }
            else pool_items(p);
        } }
    if constexpr (K == 4) {
        for (int item = blockIdx.x * NWAVES + wave; item < NB * 16 * NCH; item += G * NWAVES) lru_fixup(p, item);
        pg8::Gemm g{p.pooled, p.WpT, T, DLRU, 256, DLRU, 256, 512}; pg8::StaticOrder S; S.init(T, DLRU, G, blockIdx.x); pg8::EpiBf16 E{p.ycat + DLRU, Dm};
        pg8::gemm_phase<pg8::EpiBf16, pg8::StaticOrder>(lds, g, S, E); }
    if constexpr (K == 5) { pg8::Gemm g{p.ycat, p.WoutT, T, Dm, Dm, Dm, Dm, 0}; pg8::StaticOrder S; S.init(T, Dm, G, blockIdx.x); pg8::EpiGateBf16 E{p.d1, p.mod + 2 * Dm};
        pg8::gemm_phase<pg8::EpiGateBf16, pg8::StaticOrder>(lds, g, S, E); }
    if constexpr (K == 6) { phase_norm<1>(p.x, p.d1, nullptr, p.g_ffn, p.mod + 3 * Dm, p.mod + 4 * Dm, p.HB, nullptr); }
    if constexpr (K == 7) { pg8::Gemm g{p.HB, p.WguT, T, NGU, Dm, Dm, Dm, 0}; pg8::StaticOrder S; S.init(T, NGU, G, blockIdx.x); pg8::EpiSwiglu E{p.act};
        pg8::gemm_phase<pg8::EpiSwiglu, pg8::StaticOrder>(lds, g, S, E); }
    if constexpr (K == 8) { pg8::Gemm g{p.act, p.WdT, T, Dm, DFF, DFF, DFF, 0}; pg8::StaticOrder S; S.init(T, Dm, G, blockIdx.x); pg8::EpiGateBf16 E{p.d2, p.mod + 5 * Dm};
        pg8::gemm_phase<pg8::EpiGateBf16, pg8::StaticOrder>(lds, g, S, E); }
    if constexpr (K == 9) { phase_norm<2>(nullptr, p.d1, p.d2, p.g_final, nullptr, nullptr, nullptr, p.out); }
}
#define DO_PHASE(k) SYNC_BEFORE(k) if (PH_ON(k) && ph_lo <= (k) && (k) < ph_hi) { run_phase<k>(p, lds); if (NREP(k) > 1) { xcd_barrier(xb); run_phase<k>(p, lds); } }
__global__ void __launch_bounds__(NTHREADS, 2) fwd_megakernel(Params p, int ph_lo, int ph_hi) {
    extern __shared__ __attribute__((aligned(16))) unsigned char shm[];
    LAS unsigned char* lds = (LAS unsigned char*)shm;
    cg::grid_group grid = cg::this_grid();
    __shared__ uint4 xb_words;
    if (threadIdx.x == 0) xb_words = make_uint4(0u, 0u, 0u, 0u);
    __syncthreads();
    const XcdBarrier xb = xcd_barrier_post(p.bar, (volatile LAS unsigned*)&xb_words);
    if (ph_lo == 0x7fffffff) grid.sync();
    DO_PHASE(0) DO_PHASE(1) DO_PHASE(2) DO_PHASE(3) DO_PHASE(4) DO_PHASE(5) DO_PHASE(6) DO_PHASE(7) DO_PHASE(8) DO_PHASE(9)
}

extern "C" void kernel_launch(void* const* d_in, const int* in_sizes, int n_in, void* d_out, int out_size, void* d_ws, size_t ws_size, hipStream_t stream) {
    constexpr size_t LDS_BYTES = pg8::STAGE_BYTES;
    static int grid_blocks = 0;
    if (!grid_blocks) {
        int dev = 0, cus = 0, per_cu = 0;
        hipGetDevice(&dev);
        hipDeviceGetAttribute(&cus, hipDeviceAttributeMultiprocessorCount, dev);
        hipFuncSetAttribute((const void*)fwd_megakernel, hipFuncAttributeMaxDynamicSharedMemorySize, (int)LDS_BYTES);
        hipOccupancyMaxActiveBlocksPerMultiprocessor(&per_cu, (const void*)fwd_megakernel, NTHREADS, LDS_BYTES);
        per_cu = 1;
        if (cus < 1) cus = 256;
        grid_blocks = cus * per_cu;
    }
    Params p{};
    const float* const* in = (const float* const*)d_in;
    p.x = in[0]; p.c = in[1]; p.w_ada = in[2]; p.b_ada = in[3]; p.g_mix = in[4]; p.w_in = in[5]; p.w_conv = in[6]; p.b_conv = in[7];
    p.w_rg_a = in[8]; p.b_rg_a = in[9]; p.w_rg_i = in[10]; p.b_rg_i = in[11]; p.lam = in[12]; p.w_pool = in[13]; p.ls_pool = in[14];
    p.w_out = in[15]; p.g_ffn = in[16]; p.w_gate = in[17]; p.w_up = in[18]; p.w_down = in[19]; p.g_final = in[20];
    p.out = (float*)d_out;
    unsigned char* ws = (unsigned char*)d_ws; size_t off = 0;
    auto take = [&](size_t bytes) { unsigned char* r = ws + off; off += (bytes + 255) & ~(size_t)255; return r; };
    p.bar = (unsigned*)take((size_t)XCD_BAR_WORDS * 4);
    p.WinT = (bf16_t*)take((size_t)NPROJ * Dm * 2);
    p.WoutT = (bf16_t*)take((size_t)Dm * Dm * 2);
    p.WguT = (bf16_t*)take((size_t)NGU * Dm * 2);
    p.WdT = (bf16_t*)take((size_t)Dm * DFF * 2);
    p.WpT = (bf16_t*)take((size_t)DLRU * 256 * 2);
    p.WAf = (bf16_t*)take((size_t)2 * 16 * 4096 * 2);
    p.mod = (float*)take((size_t)NB * NMOD * 4);
    p.aggP = (float*)take((size_t)NB * NCH * DLRU * 4);
    p.aggE = (float*)take((size_t)NB * NCH * DLRU * 4);
    p.HB = (bf16_t*)take((size_t)T * Dm * 2);
    p.d1 = (bf16_t*)take((size_t)T * Dm * 2);
    p.d2 = (bf16_t*)take((size_t)T * Dm * 2);
    unsigned char* r1 = take(0);
    p.proj = (bf16_t*)take((size_t)T * NPROJ * 2);
    p.pooled = (bf16_t*)take((size_t)T * DLRU * 2);
    p.ycat = (bf16_t*)take((size_t)T * Dm * 2);
    p.act = (bf16_t*)r1;
    p.zbuf = p.HB;
    (void)hipMemsetAsync(p.bar, 0, (size_t)XCD_BAR_WORDS * 4, stream);
    int ph_lo = 0, ph_hi = NPHASE;
    void* args[] = {&p, &ph_lo, &ph_hi};
    hipError_t e = hipLaunchCooperativeKernel((const void*)fwd_megakernel, dim3(grid_blocks), dim3(NTHREADS), args, (unsigned)LDS_BYTES, stream);
    if (e != hipSuccess) fprintf(stderr, "cooperative launch failed: %s (grid %d)\n", hipGetErrorString(e), grid_blocks);
}
```

```cpp
#include <hip/hip_runtime.h>
#include <hip/hip_cooperative_groups.h>
#include <cstdio>
#include <cstdint>
namespace cg = cooperative_groups;

#define LAS __attribute__((address_space(3)))
typedef unsigned short bf16_t;
typedef short bf16x8 __attribute__((ext_vector_type(8)));
typedef float f32x4 __attribute__((ext_vector_type(4)));
typedef unsigned u32x4 __attribute__((ext_vector_type(4)));
typedef unsigned u32x2 __attribute__((ext_vector_type(2)));

constexpr int Dm = 2048, NB = 2, SEQ = 16384, T = NB * SEQ, DLRU = 1024, NPROJ = 3072, DFF = 5632, NGU = 2 * DFF, NMOD = 6 * Dm;
constexpr int TC = 256, NCH = SEQ / TC;
constexpr int NTHREADS = 512, NWAVES = 8;
constexpr float EPS = 1e-6f;
constexpr float LOG2E = 1.4426950408889634f;

struct Params {
    const float *x, *c, *w_ada, *b_ada, *g_mix, *w_in, *w_conv, *b_conv, *w_rg_a, *b_rg_a, *w_rg_i, *b_rg_i, *lam, *w_pool, *ls_pool, *w_out, *g_ffn, *w_gate, *w_up, *w_down, *g_final;
    float* out;
    bf16_t *WinT, *WoutT, *WguT, *WdT, *WpT, *WAf;
    float *mod, *aggP, *aggE;
    bf16_t *HB, *proj, *pooled, *ycat, *act, *zbuf;
    bf16_t *d1, *d2;
    unsigned* bar;
};

__device__ __forceinline__ unsigned cvt_pk_bf16(float lo, float hi) { unsigned r; asm("v_cvt_pk_bf16_f32 %0, %1, %2" : "=v"(r) : "v"(lo), "v"(hi)); return r; }
__device__ __forceinline__ float bf_lo(unsigned w) { return __uint_as_float(w << 16); }
__device__ __forceinline__ float bf_hi(unsigned w) { return __uint_as_float(w & 0xffff0000u); }
__device__ __forceinline__ float fast_sigmoid(float v) { return __builtin_amdgcn_rcpf(1.0f + __builtin_amdgcn_exp2f(-LOG2E * v)); }
__device__ __forceinline__ float wave_sum(float v) {
#pragma unroll
    for (int o = 1; o < 64; o <<= 1) v += __shfl_xor(v, o);
    return v;
}

namespace pg8 {
constexpr int BM = 256, BK = 64, HALF = 128, HTB = HALF * BK * 2  , STAGE_BYTES = 8 * HTB, NXCD = 8, WGM = 8;

__host__ __device__ __forceinline__ int lds_byte(int r, int c) { const int st = (r >> 4) * 2 + (c >> 5), rr = r & 15, cc = c & 31, ob = rr * 64 + cc * 2; return st * 1024 + (ob ^ (((ob >> 9) & 1) << 5)); }
__host__ __device__ __forceinline__ void stage_rc(int b, int& R, int& C) { const int st = b / 1024, sb = b % 1024, swz = sb ^ (((sb >> 9) & 1) << 5); R = (st >> 1) * 16 + swz / 64; C = (st & 1) * 32 + (swz % 64) / 2; }
__host__ __device__ __forceinline__ int perm32(int rho) { const int n = rho >> 4, i = rho & 15; return 8 * (i >> 2) + 4 * n + (i & 3); }

struct Unit { int pm, pn; };
struct Gemm { const bf16_t* A; const bf16_t* Bt; int M, N, K, lda, ldb, a_pn_off; };

struct StaticOrder {
    int nM, nN, nwg, G, c;
    __host__ __device__ void init(int M, int N, int G_, int c_) { nM = M / BM; nN = N / BM; nwg = nM * nN; G = G_; c = c_; }
    __host__ __device__ bool next(int i, Unit& u) const {
        const long L = (long)i * G + c; if (L >= nwg) return false;
        int wgid = (int)L; { const int q = nwg / NXCD, r = nwg % NXCD, xcd = wgid % NXCD, off = wgid / NXCD; wgid = (xcd < r ? xcd * (q + 1) : r * (q + 1) + (xcd - r) * q) + off; }
        const int nig = WGM * nN, gid = wgid / nig, fm = gid * WGM, gsz = (nM - fm) < WGM ? (nM - fm) : WGM;
        u.pm = fm + ((wgid % nig) % gsz); u.pn = (wgid % nig) / gsz; return true;
    }
};

template <bool NT> struct EpiBf16 {
    static constexpr bool PERM = true;
    bf16_t* O; int ldc;
    __device__ __forceinline__ void operator()(const f32x4 (&acc)[2][2][4][2], const Unit& u, int wr, int wc, int fr, int fq) const {
        const int row0 = u.pm * BM + wr * 64 + fr, col0 = u.pn * BM + wc * 32 + 8 * fq;
#pragma unroll
        for (int ai = 0; ai < 2; ++ai)
#pragma unroll
            for (int m = 0; m < 4; ++m) { bf16_t* rowp = O + (size_t)(row0 + ai * HALF + m * 16) * ldc + col0;
#pragma unroll
                for (int bj = 0; bj < 2; ++bj) { const f32x4 v0 = acc[ai][bj][m][0], v1 = acc[ai][bj][m][1];
                    u32x4 w; w.x = cvt_pk_bf16(v0[0], v0[1]); w.y = cvt_pk_bf16(v0[2], v0[3]); w.z = cvt_pk_bf16(v1[0], v1[1]); w.w = cvt_pk_bf16(v1[2], v1[3]);
                    if (NT) __builtin_nontemporal_store(w, (u32x4*)(rowp + bj * HALF)); else *(u32x4*)(rowp + bj * HALF) = w; } }
    }
};
struct EpiGateBf16 {
    static constexpr bool PERM = true;
    bf16_t* O; const float* gate;
    __device__ __forceinline__ void operator()(const f32x4 (&acc)[2][2][4][2], const Unit& u, int wr, int wc, int fr, int fq) const {
        const int row0 = u.pm * BM + wr * 64 + fr, col0 = u.pn * BM + wc * 32 + 8 * fq;
        const float* gp = gate + (size_t)(u.pm >> 6) * NMOD + col0;
        f32x4 gv[2][2];
#pragma unroll
        for (int bj = 0; bj < 2; ++bj)
#pragma unroll
            for (int n = 0; n < 2; ++n) gv[bj][n] = *(const f32x4*)(gp + bj * HALF + n * 4);
#pragma unroll
        for (int ai = 0; ai < 2; ++ai)
#pragma unroll
            for (int m = 0; m < 4; ++m) { bf16_t* rowp = O + (size_t)(row0 + ai * HALF + m * 16) * Dm + col0;
#pragma unroll
                for (int bj = 0; bj < 2; ++bj) { const f32x4 v0 = acc[ai][bj][m][0] * gv[bj][0], v1 = acc[ai][bj][m][1] * gv[bj][1];
                    u32x4 w; w.x = cvt_pk_bf16(v0[0], v0[1]); w.y = cvt_pk_bf16(v0[2], v0[3]); w.z = cvt_pk_bf16(v1[0], v1[1]); w.w = cvt_pk_bf16(v1[2], v1[3]);
                    *(u32x4*)(rowp + bj * HALF) = w; } }
    }
};
struct EpiSwiglu {
    static constexpr bool PERM = true;
    bf16_t* O;
    __device__ __forceinline__ void operator()(const f32x4 (&acc)[2][2][4][2], const Unit& u, int wr, int wc, int fr, int fq) const {
        const int row0 = u.pm * BM + wr * 64 + fr, col0 = u.pn * HALF + wc * 32 + 8 * fq;
#pragma unroll
        for (int ai = 0; ai < 2; ++ai)
#pragma unroll
            for (int m = 0; m < 4; ++m) { bf16_t* rowp = O + (size_t)(row0 + ai * HALF + m * 16) * DFF + col0;
                f32x4 v0, v1;
#pragma unroll
                for (int j = 0; j < 4; ++j) { const float g0 = acc[ai][0][m][0][j], g1 = acc[ai][0][m][1][j];
                    v0[j] = g0 * fast_sigmoid(g0) * acc[ai][1][m][0][j]; v1[j] = g1 * fast_sigmoid(g1) * acc[ai][1][m][1][j]; }
                u32x4 w; w.x = cvt_pk_bf16(v0[0], v0[1]); w.y = cvt_pk_bf16(v0[2], v0[3]); w.z = cvt_pk_bf16(v1[0], v1[1]); w.w = cvt_pk_bf16(v1[2], v1[3]);
                __builtin_nontemporal_store(w, (u32x4*)rowp); }
    }
};

template <class Epi, class Sched, bool ALIGN_EPI = true>
__device__ __forceinline__ void gemm_phase(LAS unsigned char* lds, const Gemm g, const Sched& S, const Epi& E) {
    const int tid = threadIdx.x, wid = __builtin_amdgcn_readfirstlane(tid >> 6), lane = tid & 63, wr = wid >> 2, wc = wid & 3, fr = lane & 15, fq = lane >> 4;
    const int K = g.K, nt = K / BK;
    unsigned voffA[2], voffB[2];
#pragma unroll
    for (int i = 0; i < 2; ++i) { int R, C; stage_rc(tid * 16 + i * 8192, R, C); const int Rb = Epi::PERM ? ((R & ~31) + perm32(R & 31)) : R;
        voffA[i] = (unsigned)(R * g.lda + C) * 2u; voffB[i] = (unsigned)(Rb * g.ldb + C) * 2u; }
    const size_t kstep = (size_t)(BK * 2);
    const size_t hstepA = (size_t)HALF * g.lda * 2, hstepB = (size_t)HALF * g.ldb * 2;
    const size_t tstepA = 2 * hstepA, tstepB = 2 * hstepB;
    const unsigned ldsw = (unsigned)wid * 1024u;
    const int aoff = lds_byte(wr * 64 + fr, fq * 8), boff = lds_byte(wc * 32 + fr, fq * 8);
#define PG8_SA(b, h) (((b) * 2 + (h)) * HTB)
#define PG8_SB(b, h) ((4 + (b) * 2 + (h)) * HTB)
#define PG8_STAGE(bufoff, gbase, voff) do { _Pragma("unroll") for (int _i = 0; _i < 2; ++_i) \
        __builtin_amdgcn_global_load_lds((const unsigned*)((const char*)(gbase) + (voff)[_i]), (LAS unsigned*)(lds + (bufoff) + ldsw + _i * 8192), 16, 0, 0); } while (0)
#define PG8_LDA(dst, b, h) do { _Pragma("unroll") for (int m = 0; m < 4; ++m) _Pragma("unroll") for (int k = 0; k < 2; ++k) dst[m][k] = *(const LAS bf16x8*)(lds + PG8_SA(b, h) + aoff + m * 2048 + k * 1024); } while (0)
#define PG8_LDB(dst, b, h) do { _Pragma("unroll") for (int n = 0; n < 2; ++n) _Pragma("unroll") for (int k = 0; k < 2; ++k) dst[n][k] = *(const LAS bf16x8*)(lds + PG8_SB(b, h) + boff + n * 2048 + k * 1024); } while (0)
#define PG8_MMA(ai, bj, At, Bt) do { __builtin_amdgcn_s_setprio(1); _Pragma("unroll") for (int m = 0; m < 4; ++m) _Pragma("unroll") for (int n = 0; n < 2; ++n) _Pragma("unroll") for (int k = 0; k < 2; ++k) \
        acc[ai][bj][m][n] = __builtin_amdgcn_mfma_f32_16x16x32_bf16(Bt[n][k], At[m][k], acc[ai][bj][m][n], 0, 0, 0); __builtin_amdgcn_s_setprio(0); } while (0)
#define PG8_WAIT_V(n) asm volatile("s_waitcnt vmcnt(" #n ")" ::: "memory")
#define PG8_WAIT_L(n) asm volatile("s_waitcnt lgkmcnt(" #n ")" ::: "memory")
#define PG8_BAR __builtin_amdgcn_s_barrier()
#define PG8_SCHED __builtin_amdgcn_sched_barrier(0)
    Unit cur, nxt; int ui = 0;
    if (!S.next(0, cur)) return;
    f32x4 acc[2][2][4][2];
#pragma unroll
    for (int a = 0; a < 2; ++a)
#pragma unroll
        for (int b = 0; b < 2; ++b)
#pragma unroll
            for (int m = 0; m < 4; ++m)
#pragma unroll
                for (int n = 0; n < 2; ++n) acc[a][b][m][n] = (f32x4){0.f, 0.f, 0.f, 0.f};
    bf16x8 At[4][2], B0[2][2], B1[2][2];
    const char* cA = (const char*)g.A + (size_t)cur.pm * tstepA + (size_t)cur.pn * g.a_pn_off; const char* cB = (const char*)g.Bt + (size_t)cur.pn * tstepB;
    PG8_STAGE(PG8_SB(0, 0), cB, voffB); PG8_STAGE(PG8_SB(0, 1), cB + hstepB, voffB); PG8_STAGE(PG8_SA(0, 0), cA, voffA); PG8_STAGE(PG8_SA(0, 1), cA + hstepA, voffA);
    if (wr == 1) PG8_BAR;
    PG8_WAIT_V(2); PG8_BAR;
    PG8_STAGE(PG8_SB(1, 0), cB + kstep, voffB); PG8_STAGE(PG8_SA(1, 0), cA + kstep, voffA); PG8_STAGE(PG8_SB(1, 1), cB + hstepB + kstep, voffB);
    PG8_WAIT_V(6); PG8_BAR;
    for (;;) {
        const bool has_next = S.next(ui + 1, nxt);
        const char* nA = has_next ? (const char*)g.A + (size_t)nxt.pm * tstepA + (size_t)nxt.pn * g.a_pn_off : cA; const char* nB = has_next ? (const char*)g.Bt + (size_t)nxt.pn * tstepB : cB;
        for (int t = 0; t < nt; t += 2) {
            const bool last = (t == nt - 2);
            const char* a1 = cA + (size_t)(t + 1) * kstep;
            const char* a2 = last ? nA : cA + (size_t)(t + 2) * kstep; const char* b2 = last ? nB : cB + (size_t)(t + 2) * kstep;
            const char* a3 = a2 + kstep; const char* b3 = b2 + kstep;
            PG8_LDB(B0, 0, 0); PG8_LDB(B1, 0, 1); PG8_SCHED; PG8_LDA(At, 0, 0); PG8_STAGE(PG8_SA(1, 1), a1 + hstepA, voffA);
            PG8_WAIT_V(8); PG8_WAIT_L(0); PG8_BAR; PG8_MMA(0, 0, At, B0); PG8_MMA(0, 1, At, B1); PG8_BAR; PG8_SCHED;
            PG8_LDA(At, 0, 1); PG8_STAGE(PG8_SB(0, 0), b2, voffB); PG8_STAGE(PG8_SB(0, 1), b2 + hstepB, voffB); PG8_STAGE(PG8_SA(0, 0), a2, voffA);
            PG8_WAIT_V(8); PG8_WAIT_L(0); PG8_BAR; PG8_MMA(1, 0, At, B0); PG8_MMA(1, 1, At, B1); PG8_BAR; PG8_SCHED;
            PG8_LDB(B0, 1, 0); PG8_LDB(B1, 1, 1); PG8_SCHED; PG8_LDA(At, 1, 0); PG8_STAGE(PG8_SA(0, 1), a2 + hstepA, voffA);
            PG8_WAIT_V(8); PG8_WAIT_L(0); PG8_BAR; PG8_MMA(0, 0, At, B0); PG8_MMA(0, 1, At, B1); PG8_BAR; PG8_SCHED;
            PG8_LDA(At, 1, 1); PG8_STAGE(PG8_SB(1, 0), b3, voffB); PG8_STAGE(PG8_SB(1, 1), b3 + hstepB, voffB); PG8_STAGE(PG8_SA(1, 0), a3, voffA);
            PG8_WAIT_V(8); PG8_WAIT_L(0); PG8_BAR; PG8_MMA(1, 0, At, B0); PG8_MMA(1, 1, At, B1); PG8_BAR; PG8_SCHED;
        }
        if constexpr (ALIGN_EPI) { if (wr == 0) PG8_BAR; }
        E(acc, cur, wr, wc, fr, fq);
        if (!has_next) break;
#pragma unroll
        for (int a = 0; a < 2; ++a)
#pragma unroll
            for (int b = 0; b < 2; ++b)
#pragma unroll
                for (int m = 0; m < 4; ++m)
#pragma unroll
                    for (int n = 0; n < 2; ++n) acc[a][b][m][n] = (f32x4){0.f, 0.f, 0.f, 0.f};
        cur = nxt; cA = nA; cB = nB; ++ui;
        if constexpr (ALIGN_EPI) { if (wr == 1) PG8_BAR; }
    }
    PG8_WAIT_V(0);
    if constexpr (!ALIGN_EPI) { if (wr == 0) PG8_BAR; }
    PG8_BAR;
#undef PG8_SA
#undef PG8_SB
#undef PG8_STAGE
#undef PG8_LDA
#undef PG8_LDB
#undef PG8_MMA
#undef PG8_WAIT_V
#undef PG8_WAIT_L
#undef PG8_BAR
#undef PG8_SCHED
}
}

__device__ __forceinline__ void mod_task(const Params& p, LAS float* lds, int jg) {
    const int tid = threadIdx.x;
    LAS float* sc = lds;
    LAS float* red = lds + 4096;
    for (int i = tid; i < NB * Dm; i += NTHREADS) { const float v = p.c[i]; sc[i] = v * fast_sigmoid(v); }
    __syncthreads();
    const int c4 = tid & 31, ks = tid >> 5;
    const float* wp = p.w_ada + (size_t)(ks * 128) * NMOD + jg * 128 + c4 * 4;
    f32x4 a0 = (f32x4){0.f, 0.f, 0.f, 0.f}, a1 = a0;
#pragma unroll 16
    for (int kk = 0; kk < 128; ++kk) {
        const f32x4 w = __builtin_nontemporal_load((const f32x4*)(wp + (size_t)kk * NMOD));
        const float s0 = sc[ks * 128 + kk], s1 = sc[Dm + ks * 128 + kk];
        a0 += s0 * w; a1 += s1 * w;
    }
    *(LAS f32x4*)(red + (ks * 2 + 0) * 128 + c4 * 4) = a0;
    *(LAS f32x4*)(red + (ks * 2 + 1) * 128 + c4 * 4) = a1;
    __syncthreads();
    if (tid < 256) { const int b = tid >> 7, j = tid & 127; float s = p.b_ada[jg * 128 + j];
#pragma unroll
        for (int k2 = 0; k2 < 16; ++k2) s += red[(k2 * 2 + b) * 128 + j];
        p.mod[(size_t)b * NMOD + jg * 128 + j] = s; }
    __syncthreads();
}
__device__ __forceinline__ void transpose_item(const float* src, int N, bf16_t* dst, int ldd, int mode, const float* scale, int item, LAS float* scr, int lane) {
    const int nblk = N >> 5, kb = item / nblk, nb = item - kb * nblk, k0 = kb * 64, n0 = nb * 32;
    const float* s0 = src + (size_t)(k0 + (lane >> 3)) * N + n0 + (lane & 7) * 4;
    f32x4 v[8];
#pragma unroll
    for (int i = 0; i < 8; ++i) v[i] = __builtin_nontemporal_load((const f32x4*)(s0 + (size_t)(8 * i) * N));
    asm volatile("" ::: "memory"); __builtin_amdgcn_wave_barrier();
#pragma unroll
    for (int i = 0; i < 8; ++i) { LAS float* d = scr + (8 * i + (lane >> 3)) * 33 + (lane & 7) * 4; d[0] = v[i][0]; d[1] = v[i][1]; d[2] = v[i][2]; d[3] = v[i][3]; }
    asm volatile("" ::: "memory"); __builtin_amdgcn_wave_barrier();
    const int c = lane & 7;
#pragma unroll
    for (int j = 0; j < 4; ++j) { const int n = (lane >> 3) + 8 * j, nn = n0 + n; const LAS float* s = scr + (8 * c) * 33 + n;
        const float sc = scale ? scale[nn] : 1.0f;
        u32x4 o; o.x = cvt_pk_bf16(s[0] * sc, s[33] * sc); o.y = cvt_pk_bf16(s[2 * 33] * sc, s[3 * 33] * sc); o.z = cvt_pk_bf16(s[4 * 33] * sc, s[5 * 33] * sc); o.w = cvt_pk_bf16(s[6 * 33] * sc, s[7 * 33] * sc);
        const int drow = mode == 0 ? nn : (256 * (nn >> 7) + (nn & 127) + (mode == 2 ? 128 : 0));
        *(u32x4*)(dst + (size_t)drow * ldd + k0 + 8 * c) = o; }
    asm volatile("" ::: "memory"); __builtin_amdgcn_wave_barrier();
}
__device__ __forceinline__ void phase0(const Params& p, LAS float* lds) {
    const int G = gridDim.x, lane = threadIdx.x & 63, wave = threadIdx.x >> 6;
    constexpr int T_MOD = NMOD / 128;
    for (int task = blockIdx.x; task < T_MOD; task += G) mod_task(p, lds, task);
    constexpr int I_IN = (Dm / 64) * (NPROJ / 32), I_OUT = (Dm / 64) * (Dm / 32), I_G = (Dm / 64) * (DFF / 32), I_D = (DFF / 64) * (Dm / 32), I_P = 4 * 4 * 8;
    constexpr int NITEMS = I_IN + I_OUT + 2 * I_G + I_D + I_P, SKIP = 6;
    const int nmodb = G < T_MOD ? G : T_MOD, NW_NON = (G - nmodb) * NWAVES, NGW = G * NWAVES;
    const bool is_mod = (int)blockIdx.x < nmodb;
    const int vw = is_mod ? NW_NON + blockIdx.x * NWAVES + wave : (blockIdx.x - nmodb) * NWAVES + wave;
    const int skip = NW_NON > 0 ? SKIP : 0;
    LAS float* scr = lds + wave * (64 * 33);
    for (int r = 0;; ++r) {
        int it;
        if (r < skip) { if (is_mod) continue; it = r * NW_NON + vw; } else it = skip * NW_NON + (r - skip) * NGW + vw;
        if (it >= NITEMS) break;
        if (it < I_IN) { transpose_item(p.w_in, NPROJ, p.WinT, Dm, 0, nullptr, it, scr, lane); continue; } it -= I_IN;
        if (it < I_OUT) { transpose_item(p.w_out, Dm, p.WoutT, Dm, 0, nullptr, it, scr, lane); continue; } it -= I_OUT;
        if (it < I_G) { transpose_item(p.w_gate, DFF, p.WguT, Dm, 1, nullptr, it, scr, lane); continue; } it -= I_G;
        if (it < I_G) { transpose_item(p.w_up, DFF, p.WguT, Dm, 2, nullptr, it, scr, lane); continue; } it -= I_G;
        if (it < I_D) { transpose_item(p.w_down, Dm, p.WdT, DFF, 0, nullptr, it, scr, lane); continue; } it -= I_D;
        { const int gidx = it >> 5; transpose_item(p.w_pool + (size_t)gidx * 65536, 256, p.WpT + (size_t)gidx * 65536, 256, 0, p.ls_pool + gidx * 256, it & 31, scr, lane); }
    }
    for (int e = blockIdx.x * NTHREADS + threadIdx.x; e < 2 * 16 * 4096; e += G * NTHREADS) {
        const int el = e & 7, ln = (e >> 3) & 63, ks = (e >> 9) & 1, mt = (e >> 10) & 3, h = (e >> 12) & 15, gate = e >> 16;
        const int in = ks * 32 + (ln >> 4) * 8 + el, out = mt * 16 + (ln & 15);
        const float* w = gate ? p.w_rg_i : p.w_rg_a;
        p.WAf[e] = (bf16_t)(cvt_pk_bf16(w[(size_t)(h * 64 + in) * 64 + out], 0.f) & 0xffffu);
    }
}

template <int MODE>
__device__ __forceinline__ void phase_norm(const float* xin, bf16_t* d1, const bf16_t* d2, const float* g, const float* sh, const float* sc, bf16_t* hb, float* outf) {
    constexpr bool FINAL = (MODE == 2);
    const int lane = threadIdx.x & 63, wave = threadIdx.x >> 6;
    const int gw = blockIdx.x * NWAVES + wave, NGW = gridDim.x * NWAVES, rpw = (T + NGW - 1) / NGW;
    const int r0 = gw * rpw, r1 = (r0 + rpw < T) ? r0 + rpw : T;
    f32x4 fv[8], sv[8];
    int curb = -1;
    struct RowBuf { f32x4 v[8]; u32x2 a[8]; u32x2 c[8]; };
    auto load_row = [&](RowBuf& rb, const int row) __attribute__((always_inline)) {
        if (row < r1) {
#pragma unroll
            for (int j = 0; j < 8; ++j) { const size_t o = (size_t)row * Dm + j * 256 + lane * 4;
                if (MODE <= 1) rb.v[j] = __builtin_nontemporal_load((const f32x4*)(xin + o));
                if (MODE == 1) rb.a[j] = __builtin_nontemporal_load((const u32x2*)(d1 + o));
                if (MODE == 2) { rb.a[j] = __builtin_nontemporal_load((const u32x2*)(d1 + o)); rb.c[j] = __builtin_nontemporal_load((const u32x2*)(d2 + o)); } }
        }
    };
    auto do_row = [&](RowBuf& rb, const int row) __attribute__((always_inline)) {
        if (row >= r1) return;
        const int b = row >> 14;
        if (b != curb) { curb = b;
#pragma unroll
            for (int j = 0; j < 8; ++j) { const int k = j * 256 + lane * 4; const f32x4 gg = *(const f32x4*)(g + k);
                if (!FINAL) { const f32x4 s = *(const f32x4*)(sc + (size_t)b * NMOD + k); fv[j] = gg * (1.0f + s); sv[j] = *(const f32x4*)(sh + (size_t)b * NMOD + k); }
                else { fv[j] = gg; sv[j] = (f32x4){0.f, 0.f, 0.f, 0.f}; } } }
        float ss = 0.f;
#pragma unroll
        for (int j = 0; j < 8; ++j) {
            if (MODE == 1) { const u32x2 w = rb.a[j]; rb.v[j] += (f32x4){bf_lo(w.x), bf_hi(w.x), bf_lo(w.y), bf_hi(w.y)};
                u32x2 xw; xw.x = cvt_pk_bf16(rb.v[j][0], rb.v[j][1]); xw.y = cvt_pk_bf16(rb.v[j][2], rb.v[j][3]);
                __builtin_nontemporal_store(xw, (u32x2*)(d1 + (size_t)row * Dm + j * 256 + lane * 4)); }
            if (MODE == 2) { const u32x2 w = rb.a[j], w2 = rb.c[j];
                rb.v[j] = (f32x4){bf_lo(w.x), bf_hi(w.x), bf_lo(w.y), bf_hi(w.y)} + (f32x4){bf_lo(w2.x), bf_hi(w2.x), bf_lo(w2.y), bf_hi(w2.y)}; }
            const f32x4 t = rb.v[j] * rb.v[j]; ss += (t[0] + t[1]) + (t[2] + t[3]);
        }
        ss = wave_sum(ss);
        const float rstd = 1.0f / sqrtf(ss * (1.0f / Dm) + EPS);
#pragma unroll
        for (int j = 0; j < 8; ++j) {
            const f32x4 o = rb.v[j] * rstd * fv[j] + sv[j];
            const size_t off = (size_t)row * Dm + j * 256 + lane * 4;
            if (!FINAL) { u32x2 w; w.x = cvt_pk_bf16(o[0], o[1]); w.y = cvt_pk_bf16(o[2], o[3]); *(u32x2*)(hb + off) = w; }
            else __builtin_nontemporal_store(o, (f32x4*)(outf + off));
        }
    };
    RowBuf A, B;
    load_row(A, r0);
#pragma unroll 1
    for (int row = r0; row < r1; row += 2) {
        load_row(B, row + 1); do_row(A, row);
        load_row(A, row + 2); do_row(B, row + 1);
    }
}

template <int CTRL> __device__ __forceinline__ float dppf(float oldv, float v) {
    return __builtin_bit_cast(float, __builtin_amdgcn_update_dpp(__builtin_bit_cast(int, oldv), __builtin_bit_cast(int, v), CTRL, 0xf, 0xf, false));
}
__device__ __forceinline__ void scan16x4(f32x4& a, f32x4& u) {
    float a0 = a[0], a1 = a[1], a2 = a[2], a3 = a[3], u0 = u[0], u1 = u[1], u2 = u[2], u3 = u[3];
#define SCAN_STEP(D) \
    "v_fmac_f32_dpp %4, %4, %0 row_shr:" #D " row_mask:0xf bank_mask:0xf\n" \
    "v_fmac_f32_dpp %5, %5, %1 row_shr:" #D " row_mask:0xf bank_mask:0xf\n" \
    "v_fmac_f32_dpp %6, %6, %2 row_shr:" #D " row_mask:0xf bank_mask:0xf\n" \
    "v_fmac_f32_dpp %7, %7, %3 row_shr:" #D " row_mask:0xf bank_mask:0xf\n" \
    "v_mul_f32_dpp %0, %0, %0 row_shr:" #D " row_mask:0xf bank_mask:0xf\n" \
    "v_mul_f32_dpp %1, %1, %1 row_shr:" #D " row_mask:0xf bank_mask:0xf\n" \
    "v_mul_f32_dpp %2, %2, %2 row_shr:" #D " row_mask:0xf bank_mask:0xf\n" \
    "v_mul_f32_dpp %3, %3, %3 row_shr:" #D " row_mask:0xf bank_mask:0xf\n"
    asm volatile("s_nop 4\n" SCAN_STEP(1) SCAN_STEP(2) SCAN_STEP(4) SCAN_STEP(8) "s_nop 1\n"
                 : "+v"(a0), "+v"(a1), "+v"(a2), "+v"(a3), "+v"(u0), "+v"(u1), "+v"(u2), "+v"(u3));
#undef SCAN_STEP
    a = (f32x4){a0, a1, a2, a3}; u = (f32x4){u0, u1, u2, u3};
}
constexpr int LMT = 2;
template <int VAR = 0>
__device__ __forceinline__ void lru_item(const Params& p, LAS float* tile  , int item) {
    const int lane = threadIdx.x & 63, fr = lane & 15, fq = lane >> 4;
    const int c = item & (NCH - 1), mg0 = ((item >> 6) & 1) * LMT, h = (item >> 7) & 15, b = item >> 11;
    const size_t rowbase = (size_t)b * SEQ;
    const int cch = h * 64 + 4 * fr;
    const f32x4 cw0 = *(const f32x4*)(p.w_conv + 0 * DLRU + cch), cw1 = *(const f32x4*)(p.w_conv + 1 * DLRU + cch), cw2 = *(const f32x4*)(p.w_conv + 2 * DLRU + cch), cw3 = *(const f32x4*)(p.w_conv + 3 * DLRU + cch);
    const f32x4 cbv = *(const f32x4*)(p.b_conv + cch);
    f32x4 ba[LMT], bi[LMT], cl[LMT];
    bf16x8 wa[LMT][2], wi[LMT][2];
#pragma unroll
    for (int mt = 0; mt < LMT; ++mt) { const int ch = h * 64 + (mg0 + mt) * 16 + fq * 4;
        ba[mt] = *(const f32x4*)(p.b_rg_a + ch); bi[mt] = *(const f32x4*)(p.b_rg_i + ch);
        const f32x4 lm = *(const f32x4*)(p.lam + ch);
#pragma unroll
        for (int j = 0; j < 4; ++j) { const float xl = lm[j]; cl[mt][j] = (8.0f * LOG2E) * (fminf(xl, 0.f) - log1pf(expf(-fabsf(xl)))); }
#pragma unroll
        for (int ks = 0; ks < 2; ++ks) {
            wa[mt][ks] = *(const bf16x8*)(p.WAf + ((size_t)(((0 * 16 + h) * 4 + mg0 + mt) * 2 + ks) * 64 + lane) * 8);
            wi[mt][ks] = *(const bf16x8*)(p.WAf + ((size_t)(((1 * 16 + h) * 4 + mg0 + mt) * 2 + ks) * 64 + lane) * 8); } }
    f32x4 st0[LMT], st1[LMT];
#pragma unroll
    for (int mt = 0; mt < LMT; ++mt) { st0[mt] = (f32x4){0.f, 0.f, 0.f, 0.f}; st1[mt] = (f32x4){1.f, 1.f, 1.f, 1.f}; }
    u32x2 raw[7]; u32x2 graw[LMT]; unsigned chk = 0;
    const bf16_t* xsrc = p.proj + (rowbase + (size_t)c * TC) * NPROJ + cch;
    const bf16_t* gsrc = p.proj + (rowbase + (size_t)c * TC + fr) * NPROJ + DLRU + h * 64 + mg0 * 16 + fq * 4;
#pragma unroll
    for (int i = 0; i < 7; ++i) { const int dt = 4 * fq - 3 + i;
        if (c * TC + dt >= 0) raw[i] = *(const u32x2*)(xsrc + (long)dt * NPROJ); else raw[i] = (u32x2){0u, 0u}; }
#pragma unroll
    for (int mt = 0; mt < LMT; ++mt) graw[mt] = *(const u32x2*)(gsrc + mt * 16);
    u32x2 rawB[7]; u32x2 grawB[LMT];
#pragma unroll
    for (int i = 0; i < 7; ++i) rawB[i] = *(const u32x2*)(xsrc + (size_t)16 * NPROJ + (long)(4 * fq - 3 + i) * NPROJ);
#pragma unroll
    for (int mt = 0; mt < LMT; ++mt) grawB[mt] = *(const u32x2*)(gsrc + (size_t)16 * NPROJ + mt * 16);
    auto tile_step = [&](const int nt, u32x2 (&raw)[7], u32x2 (&graw)[LMT]) __attribute__((always_inline)) {
        f32x4 xv[7];
#pragma unroll
        for (int i = 0; i < 7; ++i) xv[i] = (f32x4){bf_lo(raw[i].x), bf_hi(raw[i].x), bf_lo(raw[i].y), bf_hi(raw[i].y)};
        f32x4 gg[LMT];
#pragma unroll
        for (int mt = 0; mt < LMT; ++mt) gg[mt] = (f32x4){bf_lo(graw[mt].x), bf_hi(graw[mt].x), bf_lo(graw[mt].y), bf_hi(graw[mt].y)};
        if (!(VAR & 2) && nt + 2 < TC / 16) {
            const bf16_t* xn = xsrc + (size_t)(nt + 2) * 16 * NPROJ;
#pragma unroll
            for (int i = 0; i < 7; ++i) raw[i] = *(const u32x2*)(xn + (long)(4 * fq - 3 + i) * NPROJ);
#pragma unroll
            for (int mt = 0; mt < LMT; ++mt) graw[mt] = *(const u32x2*)(gsrc + (size_t)(nt + 2) * 16 * NPROJ + mt * 16);
        }
        asm volatile("" ::: "memory"); __builtin_amdgcn_wave_barrier();
#pragma unroll
        for (int j = 0; j < 4; ++j) { const f32x4 xc = cbv + cw0 * xv[j] + cw1 * xv[j + 1] + cw2 * xv[j + 2] + cw3 * xv[j + 3];
            *(LAS f32x4*)(tile + (4 * fq + j) * 68 + 4 * fr) = xc; }
        asm volatile("" ::: "memory"); __builtin_amdgcn_wave_barrier();
        bf16x8 bfr[2]; f32x4 xd[LMT];
#pragma unroll
        for (int ks = 0; ks < 2; ++ks) { const f32x4 lo = *(const LAS f32x4*)(tile + fr * 68 + ks * 32 + fq * 8), hi = *(const LAS f32x4*)(tile + fr * 68 + ks * 32 + fq * 8 + 4);
            u32x4 w; w.x = cvt_pk_bf16(lo[0], lo[1]); w.y = cvt_pk_bf16(lo[2], lo[3]); w.z = cvt_pk_bf16(hi[0], hi[1]); w.w = cvt_pk_bf16(hi[2], hi[3]);
            bfr[ks] = __builtin_bit_cast(bf16x8, w); }
#pragma unroll
        for (int mt = 0; mt < LMT; ++mt) xd[mt] = *(const LAS f32x4*)(tile + fr * 68 + (mg0 + mt) * 16 + fq * 4);
        asm volatile("" ::: "memory"); __builtin_amdgcn_wave_barrier();
        const size_t trow = rowbase + (size_t)c * TC + nt * 16 + fr;
#pragma unroll
        for (int mt = 0; mt < LMT; ++mt) {
            f32x4 dr = (f32x4){0.f, 0.f, 0.f, 0.f}, di = dr;
            dr = __builtin_amdgcn_mfma_f32_16x16x32_bf16(wa[mt][0], bfr[0], dr, 0, 0, 0); dr = __builtin_amdgcn_mfma_f32_16x16x32_bf16(wa[mt][1], bfr[1], dr, 0, 0, 0);
            di = __builtin_amdgcn_mfma_f32_16x16x32_bf16(wi[mt][0], bfr[0], di, 0, 0, 0); di = __builtin_amdgcn_mfma_f32_16x16x32_bf16(wi[mt][1], bfr[1], di, 0, 0, 0);
            f32x4 av, uv;
#pragma unroll
            for (int j = 0; j < 4; ++j) {
                const float r = fast_sigmoid(dr[j] + ba[mt][j]), ig = fast_sigmoid(di[j] + bi[mt][j]);
                const float a = __builtin_amdgcn_exp2f(r * cl[mt][j]);
                av[j] = a; uv[j] = __builtin_amdgcn_sqrtf(1.0f - a * a) * ig * xd[mt][j];
            }
            scan16x4(av, uv);
            const int ch = h * 64 + (mg0 + mt) * 16 + fq * 4;
            f32x4 y, z;
#pragma unroll
            for (int j = 0; j < 4; ++j) { const float hh = fmaf(av[j], st0[mt][j], uv[j]), zz = av[j] * st1[mt][j];
                st0[mt][j] = __shfl(hh, lane | 15); st1[mt][j] = __shfl(zz, lane | 15);
                const float gx = gg[mt][j]; const float ge = gx * fast_sigmoid(1.5957691216057308f * (gx + 0.044715f * gx * gx * gx));
                y[j] = hh * ge; z[j] = zz * ge; }
            u32x2 w; w.x = cvt_pk_bf16(y[0], y[1]); w.y = cvt_pk_bf16(y[2], y[3]);
            u32x2 w2; w2.x = cvt_pk_bf16(z[0], z[1]); w2.y = cvt_pk_bf16(z[2], z[3]);
            if (!(VAR & 1)) { *(u32x4*)(p.zbuf + trow * (2 * DLRU) + 2 * ch) = (u32x4){w.x, w.y, w2.x, w2.y}; }
            else chk += (w.x ^ w.y) + (w2.x ^ w2.y);
        }
    };
#pragma unroll 1
    for (int nt = 0; nt < TC / 16; nt += 2) { tile_step(nt, raw, graw); tile_step(nt + 1, rawB, grawB); }
    if (VAR) { if (chk == 0x12345u && st0[0][0] == 3.25f) p.aggE[0] = 1.0f; return; }
    if (fr == 15) {
#pragma unroll
        for (int mt = 0; mt < LMT; ++mt) { const size_t o = ((size_t)(b * NCH + c)) * DLRU + h * 64 + (mg0 + mt) * 16 + fq * 4;
            *(f32x4*)(p.aggE + o) = st0[mt]; *(f32x4*)(p.aggP + o) = st1[mt]; }
    }
}
__device__ __forceinline__ void lru_fixup(const Params& p, int item) {
    const int lane = threadIdx.x & 63, q = lane & 15;
    const int c = item & (NCH - 1), h = (item >> 6) & 15, b = item >> 10;
    float hin = 0.f;
    { const float* pP = p.aggP + (size_t)(b * NCH) * DLRU + h * 64 + lane; const float* pE = p.aggE + (size_t)(b * NCH) * DLRU + h * 64 + lane;
#pragma unroll 8
      for (int cc = 0; cc < c; ++cc) hin = pP[(size_t)cc * DLRU] * hin + pE[(size_t)cc * DLRU]; }
    float cy[4];
#pragma unroll
    for (int e = 0; e < 4; ++e) cy[e] = __shfl(hin, q * 4 + e);
    const size_t row0 = (size_t)b * SEQ + (size_t)c * TC + (lane >> 4);
    bf16_t* yp = p.ycat + row0 * Dm + h * 64 + q * 4;
    const bf16_t* zp = p.zbuf + row0 * (2 * DLRU) + (h * 64 + q * 4) * 2;
#pragma unroll 8
    for (int i = 0; i < TC / 4; ++i) {
        const u32x4 w = __builtin_nontemporal_load((const u32x4*)(zp + (size_t)(4 * i) * (2 * DLRU)));
        u32x2 o;
        o.x = cvt_pk_bf16(fmaf(bf_lo(w.z), cy[0], bf_lo(w.x)), fmaf(bf_hi(w.z), cy[1], bf_hi(w.x)));
        o.y = cvt_pk_bf16(fmaf(bf_lo(w.w), cy[2], bf_lo(w.y)), fmaf(bf_hi(w.w), cy[3], bf_hi(w.y)));
        *(u32x2*)(yp + (size_t)(4 * i) * Dm) = o;
    }
}
template <int W>
__device__ __forceinline__ void pool_block(const Params& p, int b, int gidx, int t0) {
    const int lane = threadIdx.x & 63;
    const bf16_t* src = p.proj + ((size_t)b * SEQ) * NPROJ + 2 * DLRU + gidx * 256 + lane * 4;
    bf16_t* dst = p.pooled + ((size_t)b * SEQ) * DLRU + gidx * 256 + lane * 4;
    u32x2 pre[W - 1], rw[2][16];
#pragma unroll
    for (int k = 0; k < W - 1; ++k) { const int tk = t0 - W + 1 + k; pre[k] = (u32x2){0u, 0u}; if (tk >= 0) pre[k] = __builtin_nontemporal_load((const u32x2*)(src + (size_t)tk * NPROJ)); }
#pragma unroll
    for (int ii = 0; ii < 16; ++ii) rw[0][ii] = __builtin_nontemporal_load((const u32x2*)(src + (size_t)(t0 + ii) * NPROJ));
    f32x4 ring[W]; f32x4 S = (f32x4){0.f, 0.f, 0.f, 0.f};
#pragma unroll
    for (int k = 0; k < W - 1; ++k) { const f32x4 v = (f32x4){bf_lo(pre[k].x), bf_hi(pre[k].x), bf_lo(pre[k].y), bf_hi(pre[k].y)}; ring[k] = v; S += v; }
    ring[W - 1] = (f32x4){0.f, 0.f, 0.f, 0.f};
#pragma unroll
    for (int grp = 0; grp < 4; ++grp) {
        if (grp + 1 < 4) {
#pragma unroll
            for (int ii = 0; ii < 16; ++ii) rw[(grp + 1) & 1][ii] = __builtin_nontemporal_load((const u32x2*)(src + (size_t)(t0 + (grp + 1) * 16 + ii) * NPROJ));
        }
#pragma unroll
        for (int ii = 0; ii < 16; ++ii) { const int t = t0 + grp * 16 + ii; const u32x2 r = rw[grp & 1][ii];
            const f32x4 x = (f32x4){bf_lo(r.x), bf_hi(r.x), bf_lo(r.y), bf_hi(r.y)};
            S += x;
            const float inv = (t + 1 < W) ? __builtin_amdgcn_rcpf((float)(t + 1)) : 1.0f / (float)W;
            const f32x4 o = S * inv - x;
            u32x2 w; w.x = cvt_pk_bf16(o[0], o[1]); w.y = cvt_pk_bf16(o[2], o[3]);
            *(u32x2*)(dst + (size_t)t * DLRU) = w;
            S -= ring[ii % W]; ring[(ii + W - 1) % W] = x; }
    }
}
__device__ __forceinline__ void pool_items(const Params& p) {
    const int wave = threadIdx.x >> 6;
    const int gw = blockIdx.x * NWAVES + wave, NGW = gridDim.x * NWAVES;
    for (int item = gw; item < NB * 4 * (SEQ / 64); item += NGW) {
        const int gidx = item & 3, blk = (item >> 2) & (SEQ / 64 - 1), b = item >> 10;
        if (gidx == 0) pool_block<2>(p, b, 0, blk * 64);
        else if (gidx == 1) pool_block<4>(p, b, 1, blk * 64);
        else if (gidx == 2) pool_block<8>(p, b, 2, blk * 64);
        else pool_block<16>(p, b, 3, blk * 64);
    }
}

#define XB_TMO      128
#define XB_XCNT(j)  (256  + 64 * (j))
#define XB_XSUB(j)  (1280 + 64 * (j))
#define XB_XGEN(j)  (2304 + 64 * (j))
#define XB_TOP      3328
#define XB_TOPGEN   3392
#define XCD_BAR_WORDS 3456
#define XB_SPIN_CAP (1u << 18)
__device__ __forceinline__ unsigned xb_ld(unsigned* p)              { return __hip_atomic_load(p, __ATOMIC_RELAXED, __HIP_MEMORY_SCOPE_AGENT); }
__device__ __forceinline__ unsigned xb_add(unsigned* p, unsigned v) { return __hip_atomic_fetch_add(p, v, __ATOMIC_RELAXED, __HIP_MEMORY_SCOPE_AGENT); }
__device__ __forceinline__ unsigned xb_xcc_id() { return (unsigned)__builtin_amdgcn_s_getreg((3 << 11) | 20) & 0xFu; }
#define XB_SPIN(cond, bar) do { unsigned _sp = 0; while (cond) { __builtin_amdgcn_s_sleep(1); \
    if ((++_sp & 255u) == 0u) { if (xb_ld(&(bar)[XB_TMO])) break; if (_sp > XB_SPIN_CAP) { atomicAdd(&(bar)[XB_TMO], 1u); break; } } } } while (0)
struct XcdBarrier { unsigned* bar; unsigned x; volatile LAS unsigned* st; };
__device__ __forceinline__ XcdBarrier xcd_barrier_post(unsigned* bar, volatile LAS unsigned* st) {
    XcdBarrier b; b.bar = bar; b.x = xb_xcc_id(); b.st = st;
    if (threadIdx.x == 0) (void)xb_add(&bar[XB_XCNT(b.x)], 1u);
    return b;
}
__device__ __forceinline__ void xcd_barrier_complete(unsigned* bar, unsigned x, unsigned& nloc, unsigned& nx) {
    const unsigned G = gridDim.x * gridDim.y * gridDim.z;
    unsigned sum, cnt, mine, sp = 0u;
    for (;;) {
        sum = 0u; cnt = 0u; mine = 0u;
#pragma unroll
        for (unsigned j = 0; j < 16; ++j) { const unsigned c = xb_ld(&bar[XB_XCNT(j)]); sum += c; cnt += (c > 0u) ? 1u : 0u; mine = (j == x) ? c : mine; }
        if (sum == G) break;
        __builtin_amdgcn_s_sleep(1);
        if ((++sp & 255u) == 0u) { if (xb_ld(&bar[XB_TMO])) break; if (sp > XB_SPIN_CAP) { atomicAdd(&bar[XB_TMO], 1u); break; } }
    }
    nloc = mine > 0u ? mine : 1u; nx = cnt > 0u ? cnt : 1u;
}
__device__ __forceinline__ void xcd_barrier(const XcdBarrier& b) {
    asm volatile("s_waitcnt vmcnt(0)" ::: "memory");
    __syncthreads();
    if (threadIdx.x == 0) {
        unsigned* bar = b.bar;
        __builtin_amdgcn_s_waitcnt(0);
        unsigned nloc = b.st[0], nx = b.st[1];
        if (nloc == 0u) { xcd_barrier_complete(bar, b.x, nloc, nx); b.st[0] = nloc; b.st[1] = nx; }
        const unsigned old = xb_add(&bar[XB_XSUB(b.x)], 1u);
        const unsigned gen = old / nloc;
        if (old + 1u == (gen + 1u) * nloc) {
            __builtin_amdgcn_fence(__ATOMIC_RELEASE, "agent");
            asm volatile("s_waitcnt vmcnt(0)" ::: "memory");
            const unsigned og = xb_add(&bar[XB_TOP], 1u);
            const unsigned tg = og / nx;
            if (og + 1u == (tg + 1u) * nx) xb_add(&bar[XB_TOPGEN], 1u);
            else XB_SPIN(xb_ld(&bar[XB_TOPGEN]) == tg, bar);
            __builtin_amdgcn_fence(__ATOMIC_ACQUIRE, "agent");
            xb_add(&bar[XB_XGEN(b.x)], 1u);
            asm volatile("s_waitcnt vmcnt(0)" ::: "memory");
        } else {
            XB_SPIN(xb_ld(&bar[XB_XGEN(b.x)]) == gen, bar);
            __builtin_amdgcn_fence(__ATOMIC_ACQUIRE, "agent");
            asm volatile("s_waitcnt vmcnt(0)" ::: "memory");
        }
    }
    __syncthreads();
}

constexpr int NPHASE = 10;
#ifndef PHMASK
#define PHMASK 0x3ff
#endif
#define PH_ON(k) (((PHMASK) >> (k)) & 1)
#define SYNC_BEFORE(k) if (ph_lo < (k) && (k) < ph_hi) xcd_barrier(xb);
#ifndef PROBE_SUB
#define PROBE_SUB 0
#endif
#ifndef DUPMASK
#define DUPMASK 0
#endif
#define NREP(k) ((((DUPMASK) >> (k)) & 1) ? 2 : 1)
template <int K>
__device__ __forceinline__ void run_phase(const Params& p, LAS unsigned char* lds) {
    const int G = gridDim.x, wave = threadIdx.x >> 6;
    if constexpr (K == 0) { phase0(p, (LAS float*)lds); }
    if constexpr (K == 1) { phase_norm<0>(p.x, nullptr, nullptr, p.g_mix, p.mod + 0 * Dm, p.mod + 1 * Dm, p.HB, nullptr); }
    if constexpr (K == 2) { pg8::Gemm g{p.HB, p.WinT, T, NPROJ, Dm, Dm, Dm, 0}; pg8::StaticOrder S; S.init(T, NPROJ, G, blockIdx.x); pg8::EpiBf16<true> E{p.proj, NPROJ};
        pg8::gemm_phase<pg8::EpiBf16<true>, pg8::StaticOrder>(lds, g, S, E); }
    if constexpr (K == 3) {
#pragma unroll 1
        for (int s = 0; s < 2; ++s) {
            if (((s ^ (wave >> 2)) & 1) == 0) { for (int item = blockIdx.x * NWAVES + wave; item < NB * 16 * (4 / LMT) * NCH; item += G * NWAVES) lru_item(p, (LAS float*)lds + wave * (16 * 68), item); }
            else pool_items(p);
        } }
    if constexpr (K == 4) {
        for (int item = blockIdx.x * NWAVES + wave; item < NB * 16 * NCH; item += G * NWAVES) lru_fixup(p, item);
        pg8::Gemm g{p.pooled, p.WpT, T, DLRU, 256, DLRU, 256, 512}; pg8::StaticOrder S; S.init(T, DLRU, G, blockIdx.x); pg8::EpiBf16<false> E{p.ycat + DLRU, Dm};
        pg8::gemm_phase<pg8::EpiBf16<false>, pg8::StaticOrder>(lds, g, S, E); }
    if constexpr (K == 5) { pg8::Gemm g{p.ycat, p.WoutT, T, Dm, Dm, Dm, Dm, 0}; pg8::StaticOrder S; S.init(T, Dm, G, blockIdx.x); pg8::EpiGateBf16 E{p.d1, p.mod + 2 * Dm};
        pg8::gemm_phase<pg8::EpiGateBf16, pg8::StaticOrder>(lds, g, S, E); }
    if constexpr (K == 6) { phase_norm<1>(p.x, p.d1, nullptr, p.g_ffn, p.mod + 3 * Dm, p.mod + 4 * Dm, p.HB, nullptr); }
    if constexpr (K == 7) { pg8::Gemm g{p.HB, p.WguT, T, NGU, Dm, Dm, Dm, 0}; pg8::StaticOrder S; S.init(T, NGU, G, blockIdx.x); pg8::EpiSwiglu E{p.act};
        pg8::gemm_phase<pg8::EpiSwiglu, pg8::StaticOrder>(lds, g, S, E); }
    if constexpr (K == 8) { pg8::Gemm g{p.act, p.WdT, T, Dm, DFF, DFF, DFF, 0}; pg8::StaticOrder S; S.init(T, Dm, G, blockIdx.x); pg8::EpiGateBf16 E{p.d2, p.mod + 5 * Dm};
        pg8::gemm_phase<pg8::EpiGateBf16, pg8::StaticOrder>(lds, g, S, E); }
    if constexpr (K == 9) { phase_norm<2>(nullptr, p.d1, p.d2, p.g_final, nullptr, nullptr, nullptr, p.out); }
}
#define DO_PHASE(k) SYNC_BEFORE(k) if (PH_ON(k) && ph_lo <= (k) && (k) < ph_hi) { run_phase<k>(p, lds); if (NREP(k) > 1) { xcd_barrier(xb); run_phase<k>(p, lds); } }
__global__ void __launch_bounds__(NTHREADS, 2) fwd_megakernel(Params p, int ph_lo, int ph_hi) {
    extern __shared__ __attribute__((aligned(16))) unsigned char shm[];
    LAS unsigned char* lds = (LAS unsigned char*)shm;
    cg::grid_group grid = cg::this_grid();
    __shared__ uint4 xb_words;
    if (threadIdx.x == 0) xb_words = make_uint4(0u, 0u, 0u, 0u);
    __syncthreads();
    const XcdBarrier xb = xcd_barrier_post(p.bar, (volatile LAS unsigned*)&xb_words);
    if (ph_lo == 0x7fffffff) grid.sync();
    DO_PHASE(0) DO_PHASE(1) DO_PHASE(2) DO_PHASE(3) DO_PHASE(4) DO_PHASE(5) DO_PHASE(6) DO_PHASE(7) DO_PHASE(8) DO_PHASE(9)
}

extern "C" void kernel_launch(void* const* d_in, const int* in_sizes, int n_in, void* d_out, int out_size, void* d_ws, size_t ws_size, hipStream_t stream) {
    constexpr size_t LDS_BYTES = pg8::STAGE_BYTES;
    static int grid_blocks = 0;
    if (!grid_blocks) {
        int dev = 0, cus = 0, per_cu = 0;
        hipGetDevice(&dev);
        hipDeviceGetAttribute(&cus, hipDeviceAttributeMultiprocessorCount, dev);
        hipFuncSetAttribute((const void*)fwd_megakernel, hipFuncAttributeMaxDynamicSharedMemorySize, (int)LDS_BYTES);
        hipOccupancyMaxActiveBlocksPerMultiprocessor(&per_cu, (const void*)fwd_megakernel, NTHREADS, LDS_BYTES);
        per_cu = 1;
        if (cus < 1) cus = 256;
        grid_blocks = cus * per_cu;
    }
    Params p{};
    const float* const* in = (const float* const*)d_in;
    p.x = in[0]; p.c = in[1]; p.w_ada = in[2]; p.b_ada = in[3]; p.g_mix = in[4]; p.w_in = in[5]; p.w_conv = in[6]; p.b_conv = in[7];
    p.w_rg_a = in[8]; p.b_rg_a = in[9]; p.w_rg_i = in[10]; p.b_rg_i = in[11]; p.lam = in[12]; p.w_pool = in[13]; p.ls_pool = in[14];
    p.w_out = in[15]; p.g_ffn = in[16]; p.w_gate = in[17]; p.w_up = in[18]; p.w_down = in[19]; p.g_final = in[20];
    p.out = (float*)d_out;
    unsigned char* ws = (unsigned char*)d_ws; size_t off = 0;
    auto take = [&](size_t bytes) { unsigned char* r = ws + off; off += (bytes + 255) & ~(size_t)255; return r; };
    p.bar = (unsigned*)take((size_t)XCD_BAR_WORDS * 4);
    p.WinT = (bf16_t*)take((size_t)NPROJ * Dm * 2);
    p.WoutT = (bf16_t*)take((size_t)Dm * Dm * 2);
    p.WguT = (bf16_t*)take((size_t)NGU * Dm * 2);
    p.WdT = (bf16_t*)take((size_t)Dm * DFF * 2);
    p.WpT = (bf16_t*)take((size_t)DLRU * 256 * 2);
    p.WAf = (bf16_t*)take((size_t)2 * 16 * 4096 * 2);
    p.mod = (float*)take((size_t)NB * NMOD * 4);
    p.aggP = (float*)take((size_t)NB * NCH * DLRU * 4);
    p.aggE = (float*)take((size_t)NB * NCH * DLRU * 4);
    p.HB = (bf16_t*)take((size_t)T * Dm * 2);
    p.d1 = (bf16_t*)take((size_t)T * Dm * 2);
    p.d2 = (bf16_t*)take((size_t)T * Dm * 2);
    unsigned char* r1 = take(0);
    p.proj = (bf16_t*)take((size_t)T * NPROJ * 2);
    p.pooled = (bf16_t*)take((size_t)T * DLRU * 2);
    p.ycat = (bf16_t*)take((size_t)T * Dm * 2);
    p.act = (bf16_t*)r1;
    p.zbuf = p.HB;
    (void)hipMemsetAsync(p.bar, 0, (size_t)XCD_BAR_WORDS * 4, stream);
    int ph_lo = 0, ph_hi = NPHASE;
    void* args[] = {&p, &ph_lo, &ph_hi};
    hipError_t e = hipLaunchCooperativeKernel((const void*)fwd_megakernel, dim3(grid_blocks), dim3(NTHREADS), args, (unsigned)LDS_BYTES, stream);
    if (e != hipSuccess) fprintf(stderr, "cooperative launch failed: %s (grid %d)\n", hipGetErrorString(e), grid_blocks);
}
```
